# Optimizing an MI355X kernel written in HIP

```python
import math
import jax
import jax.numpy as jnp
from jax import lax
import numpy as np

D_MODEL = 1024
BATCH = 32
SEQ = 256
DEPTH = 2
DEC_BATCH = 8
DEC_SEQ = 2048
PAST_LEN = 512

GRID_W = 64
N_EVEN = (DEPTH + 1) // 2
N_ODD = DEPTH // 2
N_MOD = 9
D_FF = 2816
Q_BLOCK = 128
ROPE_THETA = 10000.0
EPS = 1e-6
NEG_INF = -1e30

D_RNN = 512
RNN_BLOCKS = 8
RNN_BW = D_RNN // RNN_BLOCKS
CONV_W = 4
CONV_LEFT = 2
LRU_C = 8.0

DIFF_HEADS = 4
DIFF_HD = 64
DIFF_W = DIFF_HEADS * 2 * DIFF_HD

WIN_HEADS = 16
WIN_KV = 4
WIN_G = WIN_HEADS // WIN_KV
WIN_HD = 64
WINDOW = 128

EVEN_IN = 2 * D_RNN + 3 * DIFF_W
EVEN_MIX = D_RNN + DIFF_W
ODD_IN = (WIN_HEADS + 2 * WIN_KV) * WIN_HD
ODD_MIX = WIN_HEADS * WIN_HD

kernel_name = 'hybrid_diffusion_prefix_trunk_step'


def rmsnorm(x, g):
    xf = x.astype(jnp.float32)
    y = xf * lax.rsqrt(jnp.mean(xf * xf, axis=-1, keepdims=True) + EPS)
    return (y * g.astype(jnp.float32)).astype(x.dtype)


def modulate(x, shift, scale):
    return x * (1 + scale[:, None, :]) + shift[:, None, :]


def swiglu(x, w1, w3, w2):
    return (jax.nn.silu(x @ w1) * (x @ w3)) @ w2


def diff_lambda_init(layer):
    return 0.8 - 0.6 * math.exp(-0.3 * layer)


def grid_angles(n_tok, head_dim):
    rows = n_tok // GRID_W
    row = jnp.repeat(jnp.arange(rows), GRID_W).astype(jnp.float32)
    col = jnp.tile(jnp.arange(GRID_W), rows).astype(jnp.float32)
    half = head_dim // 2
    inv = ROPE_THETA ** (-jnp.arange(0, half, 2, dtype=jnp.float32) / half)
    return row[:, None] * inv[None, :], col[:, None] * inv[None, :]


def rope_rotate(x, ang):
    n = x.shape[-1] // 2
    x1, x2 = x[..., :n], x[..., n:]
    c = jnp.cos(ang).astype(x.dtype)
    s = jnp.sin(ang).astype(x.dtype)
    return jnp.concatenate([x1 * c - x2 * s, x2 * c + x1 * s], axis=-1)


def axial_rope(x, ang_row, ang_col):
    shape = (1, x.shape[1]) + (1,) * (x.ndim - 3) + (ang_row.shape[-1],)
    half = x.shape[-1] // 2
    return jnp.concatenate([rope_rotate(x[..., :half], ang_row.reshape(shape)),
                            rope_rotate(x[..., half:], ang_col.reshape(shape))], axis=-1)


def sweep_queries(fn, q):
    B, S = q.shape[0], q.shape[1]
    nb = S // Q_BLOCK
    qb = jnp.moveaxis(q.reshape((B, nb, Q_BLOCK) + q.shape[2:]), 1, 0)
    out = lax.map(lambda args: fn(args[0], args[1]), (jnp.arange(nb), qb))
    return jnp.moveaxis(out, 0, 1).reshape((B, S) + out.shape[3:])


def centred_dwconv(x, w, b):
    S = x.shape[1]
    xp = jnp.pad(x, ((0, 0), (CONV_LEFT, CONV_W - 1 - CONV_LEFT), (0, 0)))
    y = b
    for tap in range(CONV_W):
        y = y + xp[:, tap:tap + S] * w[tap]
    return y


def _lin_combine(left, right):
    a1, b1 = left
    a2, b2 = right
    return a1 * a2, a2 * b1 + b2


def rglru_scan(xc, wa, ba, wi, bi, lam, h0, reverse):
    B, S, _ = xc.shape
    xb = xc.reshape(B, S, RNN_BLOCKS, RNN_BW)
    r = jax.nn.sigmoid(jnp.einsum('bsnk,nkj->bsnj', xb, wa).reshape(B, S, D_RNN) + ba)
    i = jax.nn.sigmoid(jnp.einsum('bsnk,nkj->bsnj', xb, wi).reshape(B, S, D_RNN) + bi)
    log_a = -LRU_C * r.astype(jnp.float32) * jax.nn.softplus(-lam.astype(jnp.float32))
    a = jnp.exp(log_a)
    u = jnp.sqrt(-jnp.expm1(2.0 * log_a)) * (i * xc).astype(jnp.float32)
    A, Bc = lax.associative_scan(_lin_combine, (a, u), reverse=reverse, axis=1)
    h = A * h0.astype(jnp.float32)[:, None, :] + Bc
    last = h[:, 0] if reverse else h[:, -1]
    return h, last


def diff_attn_block(qb, k, v, lam):
    s = jnp.einsum('bqhmd,bthmd->bhmqt', qb, k).astype(jnp.float32)
    p = jax.nn.softmax(s, axis=-1)
    w = (p[:, :, 0] - lam * p[:, :, 1]).astype(v.dtype)
    return jnp.einsum('bhqt,bthe->bqhe', w, v)


def gqa_sink_block(qb, k, v, mask, sink):
    s = jnp.einsum('bqkgd,btkd->bkgqt', qb, k).astype(jnp.float32)
    if mask is not None:
        s = jnp.where(mask, s, NEG_INF)
    sink_b = sink[None, :, :, None]
    m = jnp.maximum(jnp.max(s, axis=-1), sink_b)
    p = jnp.exp(s - m[..., None])
    denom = jnp.sum(p, axis=-1) + jnp.exp(sink_b - m)
    w = (p / denom[..., None]).astype(v.dtype)
    return jnp.einsum('bkgqt,btkd->bqkgd', w, v)


def even_mixer(h, w_in, w_out, conv_w, conv_b, lru_wa, lru_ba, lru_wi, lru_bi, lru_lam,
               q_g, k_g, lam_vec, subln_g, lam_init, h0, ctx_kv, ang):
    B, S, _ = h.shape
    xr, gt, q, k, v = jnp.split(h @ w_in, [D_RNN, 2 * D_RNN, 2 * D_RNN + DIFF_W, 2 * D_RNN + 2 * DIFF_W], axis=-1)
    xc = centred_dwconv(xr, conv_w, conv_b)
    h_fwd, last_fwd = rglru_scan(xc, lru_wa[0], lru_ba[0], lru_wi[0], lru_bi[0], lru_lam[0], h0[:, 0], False)
    h_bwd, last_bwd = rglru_scan(xc, lru_wa[1], lru_ba[1], lru_wi[1], lru_bi[1], lru_lam[1], h0[:, 1], True)
    y_rnn = (h_fwd + h_bwd).astype(h.dtype) * jax.nn.gelu(gt)
    q = rmsnorm(q.reshape(B, S, DIFF_HEADS, 2, DIFF_HD), q_g)
    k = rmsnorm(k.reshape(B, S, DIFF_HEADS, 2, DIFF_HD), k_g)
    v = v.reshape(B, S, DIFF_HEADS, 2 * DIFF_HD)
    lf = lam_vec.astype(jnp.float32)
    lam = jnp.exp(jnp.sum(lf[0] * lf[1])) - jnp.exp(jnp.sum(lf[2] * lf[3])) + lam_init
    if ctx_kv is None:
        k_all, v_all = k, v
        new_ctx = (k.reshape(B, S, DIFF_HEADS, 2 * DIFF_HD), v,
                   jnp.stack([last_fwd, last_bwd], axis=1).astype(h.dtype))
    else:
        q = axial_rope(q, ang[0], ang[1])
        k = axial_rope(k, ang[0], ang[1])
        ck, cv = ctx_kv
        k_all = jnp.concatenate([ck.reshape(B, ck.shape[1], DIFF_HEADS, 2, DIFF_HD), k], axis=1)
        v_all = jnp.concatenate([cv, v], axis=1)
        new_ctx = None
    q = q * (DIFF_HD ** -0.5)
    o = sweep_queries(lambda bi_, qb: diff_attn_block(qb, k_all, v_all, lam), q)
    o = rmsnorm(o, subln_g) * (1.0 - lam_init)
    out = jnp.concatenate([y_rnn, o.reshape(B, S, DIFF_W)], axis=-1) @ w_out
    return out, new_ctx


def odd_mixer(h, w_in, w_out, q_g, k_g, sink, ctx_kv, ang):
    B, S, _ = h.shape
    q, k, v = jnp.split(h @ w_in, [WIN_HEADS * WIN_HD, (WIN_HEADS + WIN_KV) * WIN_HD], axis=-1)
    q = rmsnorm(q.reshape(B, S, WIN_KV, WIN_G, WIN_HD), q_g)
    k = rmsnorm(k.reshape(B, S, WIN_KV, WIN_HD), k_g)
    v = v.reshape(B, S, WIN_KV, WIN_HD)
    sk = sink.reshape(WIN_KV, WIN_G).astype(jnp.float32)
    scale = WIN_HD ** -0.5
    if ctx_kv is None:
        q = q * scale
        o = sweep_queries(lambda bi_, qb: gqa_sink_block(qb, k, v, None, sk), q)
        new_ctx = (k, v)
    else:
        q = axial_rope(q, ang[0], ang[1]) * scale
        k = axial_rope(k, ang[0], ang[1])
        ck, cv = ctx_kv
        L = ck.shape[1]
        pad = ((0, 0), (Q_BLOCK, Q_BLOCK), (0, 0), (0, 0))
        kp = jnp.pad(k, pad)
        vp = jnp.pad(v, pad)
        span = 3 * Q_BLOCK

        def band_block(bi_, qb):
            start = bi_ * Q_BLOCK
            kl = lax.dynamic_slice_in_dim(kp, start, span, axis=1)
            vl = lax.dynamic_slice_in_dim(vp, start, span, axis=1)
            qpos = start + jnp.arange(Q_BLOCK)
            kpos = start - Q_BLOCK + jnp.arange(span)
            valid = (jnp.abs(qpos[:, None] - kpos[None, :]) <= WINDOW) & (kpos >= 0)[None, :] & (kpos < S)[None, :]
            mask = jnp.concatenate([valid, jnp.ones((Q_BLOCK, L), dtype=bool)], axis=1)
            return gqa_sink_block(qb, jnp.concatenate([kl, ck], axis=1), jnp.concatenate([vl, cv], axis=1), mask, sk)

        o = sweep_queries(band_block, q)
        new_ctx = None
    return o.reshape(B, S, ODD_MIX) @ w_out, new_ctx


def setup_inputs(seed: int = 0) -> dict:
    key = jax.random.key(seed)
    ks = iter(jax.random.split(key, 48))

    def nrm(shape, scale):
        return scale * jax.random.normal(next(ks), shape, jnp.float32)

    def gain(shape):
        return 1.0 + nrm(shape, 0.02)

    u = jax.random.uniform(next(ks), (N_EVEN, 2, D_RNN), jnp.float32, 0.9, 0.999)
    return {
        'x_prompt': nrm((BATCH, SEQ, D_MODEL), 1.0),
        'x_sample': nrm((DEC_BATCH, DEC_SEQ, D_MODEL), 1.0),
        'cache_diff_k': nrm((DEC_BATCH, N_EVEN, PAST_LEN, DIFF_HEADS, 2 * DIFF_HD), 1.0),
        'cache_diff_v': nrm((DEC_BATCH, N_EVEN, PAST_LEN, DIFF_HEADS, 2 * DIFF_HD), 1.0),
        'state_lru': nrm((DEC_BATCH, N_EVEN, 2, D_RNN), 0.5),
        'cache_win_k': nrm((DEC_BATCH, N_ODD, PAST_LEN, WIN_KV, WIN_HD), 1.0),
        'cache_win_v': nrm((DEC_BATCH, N_ODD, PAST_LEN, WIN_KV, WIN_HD), 1.0),
        'c': nrm((DEC_BATCH, D_MODEL), 1.0),
        'c_ctx': nrm((D_MODEL,), 1.0),
        'norm_g': gain((DEPTH, 3, D_MODEL)),
        'w_mod': nrm((DEPTH, D_MODEL, N_MOD * D_MODEL), 0.5 * D_MODEL ** -0.5),
        'b_mod': nrm((DEPTH, N_MOD * D_MODEL), 0.01),
        'ffn_w1': nrm((DEPTH, 2, D_MODEL, D_FF), D_MODEL ** -0.5),
        'ffn_w3': nrm((DEPTH, 2, D_MODEL, D_FF), D_MODEL ** -0.5),
        'ffn_w2': nrm((DEPTH, 2, D_FF, D_MODEL), D_FF ** -0.5),
        'e_w_in': nrm((N_EVEN, D_MODEL, EVEN_IN), D_MODEL ** -0.5),
        'e_w_out': nrm((N_EVEN, EVEN_MIX, D_MODEL), EVEN_MIX ** -0.5),
        'e_conv_w': nrm((N_EVEN, CONV_W, D_RNN), CONV_W ** -0.5),
        'e_conv_b': nrm((N_EVEN, D_RNN), 0.01),
        'e_lru_wa': nrm((N_EVEN, 2, RNN_BLOCKS, RNN_BW, RNN_BW), RNN_BW ** -0.5),
        'e_lru_ba': nrm((N_EVEN, 2, D_RNN), 0.01),
        'e_lru_wi': nrm((N_EVEN, 2, RNN_BLOCKS, RNN_BW, RNN_BW), RNN_BW ** -0.5),
        'e_lru_bi': nrm((N_EVEN, 2, D_RNN), 0.01),
        'e_lru_lam': jnp.log(u) - jnp.log1p(-u),
        'e_q_g': gain((N_EVEN, DIFF_HD)),
        'e_k_g': gain((N_EVEN, DIFF_HD)),
        'e_lam': nrm((N_EVEN, 4, DIFF_HD), 0.1),
        'e_subln_g': gain((N_EVEN, 2 * DIFF_HD)),
        'o_w_in': nrm((N_ODD, D_MODEL, ODD_IN), D_MODEL ** -0.5),
        'o_w_out': nrm((N_ODD, ODD_MIX, D_MODEL), ODD_MIX ** -0.5),
        'o_q_g': gain((N_ODD, WIN_HD)),
        'o_k_g': gain((N_ODD, WIN_HD)),
        'o_sink': nrm((N_ODD, WIN_HEADS), 1.0),
    }


def reference(x_prompt, x_sample, cache_diff_k, cache_diff_v, state_lru, cache_win_k, cache_win_v, c,
              c_ctx, norm_g, w_mod, b_mod, ffn_w1, ffn_w3, ffn_w2,
              e_w_in, e_w_out, e_conv_w, e_conv_b, e_lru_wa, e_lru_ba, e_lru_wi, e_lru_bi, e_lru_lam,
              e_q_g, e_k_g, e_lam, e_subln_g,
              o_w_in, o_w_out, o_q_g, o_k_g, o_sink):

    def trunk(x, cond, latent):
        B, S, _ = x.shape
        ang = grid_angles(S, DIFF_HD) if latent else None
        ctx_out = ([], [], [], [], [])
        for l in range(DEPTH):
            j = l // 2
            mod = jax.nn.silu(cond) @ w_mod[l] + b_mod[l]
            sh1, sc1, g1, sh2, sc2, g2, sh3, sc3, g3 = jnp.split(mod, N_MOD, axis=-1)
            x = x + 0.5 * g1[:, None] * swiglu(modulate(rmsnorm(x, norm_g[l, 0]), sh1, sc1),
                                               ffn_w1[l, 0], ffn_w3[l, 0], ffn_w2[l, 0])
            h = modulate(rmsnorm(x, norm_g[l, 1]), sh2, sc2)
            if l % 2 == 0:
                if latent:
                    h0 = state_lru[:, j]
                    ctx_kv = (cache_diff_k[:, j], cache_diff_v[:, j])
                else:
                    h0 = jnp.zeros((B, 2, D_RNN), jnp.float32)
                    ctx_kv = None
                out, new_ctx = even_mixer(h, e_w_in[j], e_w_out[j], e_conv_w[j], e_conv_b[j],
                                          e_lru_wa[j], e_lru_ba[j], e_lru_wi[j], e_lru_bi[j], e_lru_lam[j],
                                          e_q_g[j], e_k_g[j], e_lam[j], e_subln_g[j], diff_lambda_init(l),
                                          h0, ctx_kv, ang)
                if not latent:
                    ctx_out[0].append(new_ctx[0])
                    ctx_out[1].append(new_ctx[1])
                    ctx_out[2].append(new_ctx[2])
            else:
                ctx_kv = (cache_win_k[:, j], cache_win_v[:, j]) if latent else None
                out, new_ctx = odd_mixer(h, o_w_in[j], o_w_out[j], o_q_g[j], o_k_g[j], o_sink[j], ctx_kv, ang)
                if not latent:
                    ctx_out[3].append(new_ctx[0])
                    ctx_out[4].append(new_ctx[1])
            x = x + g2[:, None] * out
            x = x + 0.5 * g3[:, None] * swiglu(modulate(rmsnorm(x, norm_g[l, 2]), sh3, sc3),
                                               ffn_w1[l, 1], ffn_w3[l, 1], ffn_w2[l, 1])
        return x, ctx_out

    y_prompt, ctx_out = trunk(x_prompt, c_ctx[None, :], False)
    y_sample, _ = trunk(x_sample, c, True)
    new_diff_k = jnp.stack(ctx_out[0], axis=1)
    new_diff_v = jnp.stack(ctx_out[1], axis=1)
    new_state_lru = jnp.stack(ctx_out[2], axis=1)
    new_win_k = jnp.stack(ctx_out[3], axis=1)
    new_win_v = jnp.stack(ctx_out[4], axis=1)
    return (y_prompt, y_sample, new_diff_k, new_diff_v, new_state_lru, new_win_k, new_win_v)
```

```cpp
#include <hip/hip_runtime.h>
#include <hip/hip_cooperative_groups.h>
#include <cstdio>
namespace cg = cooperative_groups;

#define DI __device__ __forceinline__
typedef unsigned short bf16_t;
typedef short bf16x8 __attribute__((ext_vector_type(8)));
typedef float f32x4 __attribute__((ext_vector_type(4)));
typedef float f32x16 __attribute__((ext_vector_type(16)));
typedef float f32x2 __attribute__((ext_vector_type(2)));
typedef __bf16 bf16x2n __attribute__((ext_vector_type(2)));
typedef unsigned u32x4 __attribute__((ext_vector_type(4)));
typedef unsigned u32x2 __attribute__((ext_vector_type(2)));
typedef _Float16 h16x4 __attribute__((ext_vector_type(4)));

#ifndef PROBE_PH
#define PROBE_PH -1
#endif
#ifndef MULTI_LAUNCH
#define MULTI_LAUNCH 0
#endif

constexpr int MTOK = 24576, MP = 8192, DM = 1024, DFF = 2816;
constexpr int NPHASE = 24;
constexpr int LDS_BYTES = 131072;
constexpr int LDS_TOTAL = LDS_BYTES + 64;
constexpr float LOG2E = 1.4426950408889634f;

constexpr size_t MiB = 1048576;
constexpr size_t OFF_W13 = 0;
constexpr size_t SZ_W13 = (size_t)5632 * 1024 * 2;
constexpr size_t OFF_W2 = OFF_W13 + 4 * SZ_W13;
constexpr size_t SZ_W2 = (size_t)1024 * 2816 * 2;
constexpr size_t OFF_EWIN = OFF_W2 + 4 * SZ_W2;
constexpr size_t OFF_EWOUT = OFF_EWIN + (size_t)2560 * 1024 * 2;
constexpr size_t OFF_OWIN = OFF_EWOUT + (size_t)1024 * 1024 * 2;
constexpr size_t OFF_OWOUT = OFF_OWIN + (size_t)1536 * 1024 * 2;
constexpr size_t OFF_WG = OFF_OWOUT + (size_t)1024 * 1024 * 2;
constexpr size_t OFF_KDC = OFF_WG + (size_t)2048 * 512 * 2;
constexpr size_t OFF_VDC = OFF_KDC + (size_t)64 * 512 * 64 * 2;
constexpr size_t OFF_KWC = OFF_VDC + (size_t)4096 * 512 * 2;
constexpr size_t OFF_VWC = OFF_KWC + (size_t)32 * 512 * 64 * 2;
constexpr size_t OFF_MOD = OFF_VWC + (size_t)2048 * 512 * 2;
constexpr size_t OFF_CNT = OFF_MOD + (size_t)2 * 9 * 9216 * 4;
constexpr size_t OFF_POOL = 93 * MiB;
constexpr size_t P_U = OFF_POOL;
constexpr size_t P_GT = OFF_POOL;
constexpr size_t P_XR = OFF_POOL + 24 * MiB;
constexpr size_t P_QKV = OFF_POOL + 48 * MiB;
constexpr size_t P_LAU = OFF_POOL + 24 * MiB;
constexpr size_t P_ATT = OFF_POOL + 120 * MiB;
constexpr size_t P_H = OFF_POOL + 192 * MiB;
constexpr size_t WS_NEED = OFF_POOL + 240 * MiB;
constexpr size_t OFF_BAR = OFF_CNT + 8192;
static_assert(OFF_BAR + 16384 <= OFF_POOL, "ws map");
constexpr size_t CNT_BYTES = 8192;

struct Params {
    const float *x_prompt, *x_sample, *cache_diff_k, *cache_diff_v, *state_lru, *cache_win_k, *cache_win_v, *c, *c_ctx, *norm_g, *w_mod, *b_mod,
        *ffn_w1, *ffn_w3, *ffn_w2, *e_w_in, *e_w_out, *e_conv_w, *e_conv_b, *e_lru_wa, *e_lru_ba, *e_lru_wi, *e_lru_bi, *e_lru_lam, *e_q_g, *e_k_g, *e_lam,
        *e_subln_g, *o_w_in, *o_w_out, *o_q_g, *o_k_g, *o_sink;
    float* out;
    unsigned char* ws;
    int p0, p1;
};

DI int tidx() { int t = threadIdx.x; asm volatile("" : "+v"(t)); return t; }
DI unsigned pack2(float lo, float hi) { f32x2 v = {lo, hi}; bf16x2n b = __builtin_convertvector(v, bf16x2n); return __builtin_bit_cast(unsigned, b); }
DI bf16_t f2bf(float f) { return (bf16_t)(pack2(f, 0.f) & 0xffffu); }
DI float bf2f(bf16_t b) { return __uint_as_float(((unsigned)b) << 16); }
DI float bflo(unsigned w) { return __uint_as_float(w << 16); }
DI float bfhi(unsigned w) { return __uint_as_float(w & 0xffff0000u); }
DI void unpack8(const u32x4 w, float (&v)[8]) { v[0] = bflo(w.x); v[1] = bfhi(w.x); v[2] = bflo(w.y); v[3] = bfhi(w.y); v[4] = bflo(w.z); v[5] = bfhi(w.z); v[6] = bflo(w.w); v[7] = bfhi(w.w); }
DI u32x4 pack8(const float (&v)[8]) { u32x4 w; w.x = pack2(v[0], v[1]); w.y = pack2(v[2], v[3]); w.z = pack2(v[4], v[5]); w.w = pack2(v[6], v[7]); return w; }
DI float sigmoid_f(float x) { return 1.f / (1.f + __expf(-x)); }
DI float fsigmoid(float x) { return __builtin_amdgcn_rcpf(1.f + __builtin_amdgcn_exp2f(-x * 1.4426950408889634f)); }
DI float silu_f(float x) { return x / (1.f + __expf(-x)); }
DI float silu_mul(float a, float b) { const float e = __builtin_amdgcn_exp2f(-a * 1.4426950408889634f); return a * b * __builtin_amdgcn_rcpf(1.f + e); }
DI float gelu_tanh(float x) { const float u = 0.7978845608028654f * (x + 0.044715f * x * x * x); return 0.5f * x * (1.f + tanhf(u)); }
DI float xhalf_max(float x) { const auto r = __builtin_amdgcn_permlane32_swap(__float_as_uint(x), __float_as_uint(x), false, false); return fmaxf(__uint_as_float(r[0]), __uint_as_float(r[1])); }
DI int mod_row(int row) { return row < MP ? 0 : 1 + ((row - MP) >> 11); }

namespace pg8 {
#define PG8_LAS __attribute__((address_space(3)))
constexpr int BM = 256, BK = 64, HALF = 128, HTB = HALF * BK * 2, STAGE_BYTES = 8 * HTB, NXCD = 8, WGM = 8;
__host__ __device__ __forceinline__ int lds_byte(int r, int c) { const int st = (r >> 4) * 2 + (c >> 5), rr = r & 15, cc = c & 31, ob = rr * 64 + cc * 2; return st * 1024 + (ob ^ (((ob >> 9) & 1) << 5)); }
__host__ __device__ __forceinline__ void stage_rc(int b, int& R, int& C) { const int st = b / 1024, sb = b % 1024, swz = sb ^ (((sb >> 9) & 1) << 5); R = (st >> 1) * 16 + swz / 64; C = (st & 1) * 32 + (swz % 64) / 2; }
__host__ __device__ __forceinline__ int perm32(int rho) { const int n = rho >> 4, i = rho & 15; return 8 * (i >> 2) + 4 * n + (i & 3); }
struct Unit { int pm, pn; };
struct Gemm { const bf16_t* A; const bf16_t* Bt; int M, N, K, nk, kdiag; };
struct StaticOrder {
    int nM, nN, nwg, G, c;
    __device__ void init(int M, int N, int G_, int c_, int bm = BM) { nM = M / bm; nN = N / BM; nwg = nM * nN; G = G_; c = c_; }
    __device__ bool next(int i, Unit& u) const {
        const long L = (long)i * G + c; if (L >= nwg) return false;
        int wgid = (int)L; { const int q = nwg / NXCD, r = nwg % NXCD, xcd = wgid % NXCD, off = wgid / NXCD; wgid = (xcd < r ? xcd * (q + 1) : r * (q + 1) + (xcd - r) * q) + off; }
        const int nig = WGM * nN, gid = wgid / nig, fm = gid * WGM, gsz = (nM - fm) < WGM ? (nM - fm) : WGM;
        u.pm = fm + ((wgid % nig) % gsz); u.pn = (wgid % nig) / gsz; return true;
    }
    __device__ __forceinline__ void a_ready(const Unit&) const {}
    __device__ __forceinline__ void done(const Unit&) const {}
};

template <class Epi, class Sched, int MREP = 4>
__device__ __forceinline__ void gemm_phase(PG8_LAS unsigned char* lds, const Gemm g, const Sched& S, const Epi& E) {
    const int tid = tidx(), wid = __builtin_amdgcn_readfirstlane(tid >> 6), lane = tid & 63, wr = wid >> 2, wc = wid & 3, fr = lane & 15, fq = lane >> 4;
    const int K = g.K, nt = g.nk ? g.nk : K / BK;
    unsigned voffA[2], voffB[2];
#pragma unroll
    for (int i = 0; i < 2; ++i) { int R, C; stage_rc(tid * 16 + i * 8192, R, C); const int Rb = Epi::PERM ? ((R & ~31) + perm32(R & 31)) : R;
        voffA[i] = (unsigned)(R * K + C) * 2u; voffB[i] = (unsigned)(Rb * K + C) * 2u; }
    const size_t kstep = (size_t)(BK * 2);
    const size_t hstep = (size_t)(32 * MREP) * K * 2;
    const size_t hstepB = (size_t)HALF * K * 2;
    const size_t tstep = 2 * hstep, tstepB = 2 * hstepB;
    const unsigned ldsw = (unsigned)wid * 1024u;
    const int aoff = lds_byte(wr * (16 * MREP) + fr, fq * 8), boff = lds_byte(wc * 32 + fr, fq * 8);
#define PG8_SA(b, h) (((b) * 2 + (h)) * HTB)
#define PG8_SB(b, h) ((4 + (b) * 2 + (h)) * HTB)
#define PG8_STAGE(bufoff, gbase, voff) do { _Pragma("unroll") for (int _i = 0; _i < 2; ++_i) \
        __builtin_amdgcn_global_load_lds((const unsigned*)((const char*)(gbase) + (voff)[_i]), (PG8_LAS unsigned*)(lds + (bufoff) + ldsw + _i * 8192), 16, 0, 0); } while (0)
#define PG8_LDA(dst, b, h) do { _Pragma("unroll") for (int m = 0; m < MREP; ++m) _Pragma("unroll") for (int k = 0; k < 2; ++k) dst[m][k] = *(const PG8_LAS bf16x8*)(lds + PG8_SA(b, h) + aoff + m * 2048 + k * 1024); } while (0)
#define PG8_LDB(dst, b, h) do { _Pragma("unroll") for (int n = 0; n < 2; ++n) _Pragma("unroll") for (int k = 0; k < 2; ++k) dst[n][k] = *(const PG8_LAS bf16x8*)(lds + PG8_SB(b, h) + boff + n * 2048 + k * 1024); } while (0)
#define PG8_MMA(ai, bj, At, Bt) do { __builtin_amdgcn_s_setprio(1); _Pragma("unroll") for (int m = 0; m < MREP; ++m) _Pragma("unroll") for (int n = 0; n < 2; ++n) _Pragma("unroll") for (int k = 0; k < 2; ++k) \
        acc[ai][bj][m][n] = __builtin_amdgcn_mfma_f32_16x16x32_bf16(Bt[n][k], At[m][k], acc[ai][bj][m][n], 0, 0, 0); __builtin_amdgcn_s_setprio(0); } while (0)
#define PG8_WAIT_V(n) asm volatile("s_waitcnt vmcnt(" #n ")" ::: "memory")
#define PG8_WAIT_L(n) asm volatile("s_waitcnt lgkmcnt(" #n ")" ::: "memory")
#define PG8_BAR __builtin_amdgcn_s_barrier()
#define PG8_SCHED __builtin_amdgcn_sched_barrier(0)
    Unit cur, nxt; int ui = 0;
    if (!S.next(0, cur)) return;
    f32x4 acc[2][2][MREP][2];
#pragma unroll
    for (int a = 0; a < 2; ++a)
#pragma unroll
        for (int b = 0; b < 2; ++b)
#pragma unroll
            for (int m = 0; m < MREP; ++m)
#pragma unroll
                for (int n = 0; n < 2; ++n) acc[a][b][m][n] = (f32x4){0.f, 0.f, 0.f, 0.f};
    bf16x8 At[MREP][2], B0[2][2], B1[2][2];
    const char* cA = (const char*)g.A + (size_t)cur.pm * tstep + (size_t)(g.kdiag * (cur.pn & 3)) * 2; const char* cB = (const char*)g.Bt + (size_t)cur.pn * tstepB + (size_t)(g.kdiag * (cur.pn & 3)) * 2;
    S.a_ready(cur);
    PG8_STAGE(PG8_SB(0, 0), cB, voffB); PG8_STAGE(PG8_SA(0, 0), cA, voffA); PG8_STAGE(PG8_SB(0, 1), cB + hstepB, voffB); PG8_STAGE(PG8_SA(0, 1), cA + hstep, voffA);
    if (wr == 1) PG8_BAR;
    PG8_WAIT_V(4); PG8_BAR;
    PG8_STAGE(PG8_SB(1, 0), cB + kstep, voffB); PG8_STAGE(PG8_SA(1, 0), cA + kstep, voffA); PG8_STAGE(PG8_SB(1, 1), cB + hstepB + kstep, voffB);
    PG8_WAIT_V(6); PG8_BAR;
    for (;;) {
        const bool has_next = S.next(ui + 1, nxt);
        const char* nA = has_next ? (const char*)g.A + (size_t)nxt.pm * tstep + (size_t)(g.kdiag * (nxt.pn & 3)) * 2 : cA; const char* nB = has_next ? (const char*)g.Bt + (size_t)nxt.pn * tstepB + (size_t)(g.kdiag * (nxt.pn & 3)) * 2 : cB;
        for (int t = 0; t < nt; t += 2) {
            const bool last = (t == nt - 2);
            const char* a1 = cA + (size_t)(t + 1) * kstep;
            const char* a2 = last ? nA : cA + (size_t)(t + 2) * kstep; const char* b2 = last ? nB : cB + (size_t)(t + 2) * kstep;
            const char* a3 = a2 + kstep; const char* b3 = b2 + kstep;
            if (last && has_next) S.a_ready(nxt);
            PG8_LDB(B0, 0, 0); PG8_SCHED; PG8_LDA(At, 0, 0); PG8_STAGE(PG8_SA(1, 1), a1 + hstep, voffA);
            if constexpr (MREP == 4) PG8_WAIT_L(8); else PG8_WAIT_L(6); PG8_BAR; PG8_WAIT_L(0); PG8_MMA(0, 0, At, B0); PG8_BAR; PG8_SCHED;
            PG8_LDB(B1, 0, 1); PG8_STAGE(PG8_SB(0, 0), b2, voffB);
            PG8_BAR; PG8_WAIT_L(0); PG8_MMA(0, 1, At, B1); PG8_BAR;
            PG8_LDA(At, 0, 1); PG8_STAGE(PG8_SA(0, 0), a2, voffA);
            PG8_BAR; PG8_WAIT_L(0); PG8_MMA(1, 0, At, B0); PG8_BAR; PG8_SCHED;
            PG8_STAGE(PG8_SB(0, 1), b2 + hstepB, voffB);
            PG8_WAIT_V(6); PG8_BAR; PG8_MMA(1, 1, At, B1); PG8_BAR;
            PG8_LDB(B0, 1, 0); PG8_SCHED; PG8_LDA(At, 1, 0); PG8_STAGE(PG8_SA(0, 1), a2 + hstep, voffA);
            if constexpr (MREP == 4) PG8_WAIT_L(8); else PG8_WAIT_L(6); PG8_BAR; PG8_WAIT_L(0); PG8_MMA(0, 0, At, B0); PG8_BAR; PG8_SCHED;
            PG8_LDB(B1, 1, 1); PG8_STAGE(PG8_SB(1, 0), b3, voffB);
            PG8_BAR; PG8_WAIT_L(0); PG8_MMA(0, 1, At, B1); PG8_BAR;
            PG8_LDA(At, 1, 1); PG8_STAGE(PG8_SA(1, 0), a3, voffA);
            PG8_BAR; PG8_WAIT_L(0); PG8_MMA(1, 0, At, B0); PG8_BAR; PG8_SCHED;
            PG8_STAGE(PG8_SB(1, 1), b3 + hstepB, voffB);
            PG8_WAIT_V(6); PG8_BAR; PG8_MMA(1, 1, At, B1); PG8_BAR;
        }
        E(acc, cur, wr, wc, fr, fq); S.done(cur);
        if (!has_next) break;
#pragma unroll
        for (int a = 0; a < 2; ++a)
#pragma unroll
            for (int b = 0; b < 2; ++b)
#pragma unroll
                for (int m = 0; m < MREP; ++m)
#pragma unroll
                    for (int n = 0; n < 2; ++n) acc[a][b][m][n] = (f32x4){0.f, 0.f, 0.f, 0.f};
        cur = nxt; cA = nA; cB = nB; ++ui;
    }
    PG8_WAIT_V(0);
    if (wr == 0) PG8_BAR;
    PG8_BAR;
#undef PG8_SA
#undef PG8_SB
#undef PG8_STAGE
#undef PG8_LDA
#undef PG8_LDB
#undef PG8_MMA
#undef PG8_WAIT_V
#undef PG8_WAIT_L
#undef PG8_BAR
#undef PG8_SCHED
}
}
using pg8::Unit;

struct EpiSwiglu {
    static constexpr bool PERM = true;
    bf16_t* U;
    DI void operator()(const f32x4 (&acc)[2][2][4][2], const Unit& u, int wr, int wc, int fr, int fq) const {
        asm volatile("" : "+v"(fr), "+v"(fq));
        const int row0 = u.pm * 256 + wr * 64 + fr, col0 = u.pn * 128 + wc * 32 + 8 * fq;
#pragma unroll
        for (int ai = 0; ai < 2; ++ai)
#pragma unroll
            for (int m = 0; m < 4; ++m) {
                bf16_t* rowp = U + (size_t)(row0 + ai * 128 + m * 16) * DFF + col0;
                float v[8];
#pragma unroll
                for (int n = 0; n < 2; ++n)
#pragma unroll
                    for (int j = 0; j < 4; ++j) v[n * 4 + j] = silu_mul(acc[ai][0][m][n][j], acc[ai][1][m][n][j]);
                __builtin_nontemporal_store(pack8(v), (u32x4*)rowp);
            }
    }
};
struct EpiResid {
    static constexpr bool PERM = false;
    const float* xp; const float* xs; float* out; const float* gate; float coef;
    DI void operator()(const f32x4 (&acc)[2][2][4][2], const Unit& u, int wr, int wc, int fr, int fq) const {
        asm volatile("" : "+v"(fr), "+v"(fq));
        const int rowt = u.pm * 256;
        const float* gp = gate + (size_t)mod_row(rowt) * 9216;
        const float* src = rowt < MP ? xp + (size_t)rowt * DM : xs + (size_t)(rowt - MP) * DM;
        float* dst = out + (size_t)rowt * DM;
        const int r0 = wr * 64 + fr, col0 = u.pn * 256 + wc * 32 + 4 * fq;
#pragma unroll
        for (int bj = 0; bj < 2; ++bj)
#pragma unroll
            for (int n = 0; n < 2; ++n) {
                const int cc = col0 + bj * 128 + n * 16;
                f32x4 xv[2][4];
#pragma unroll
                for (int ai = 0; ai < 2; ++ai)
#pragma unroll
                    for (int m = 0; m < 4; ++m) xv[ai][m] = *(const f32x4*)(src + (size_t)(r0 + ai * 128 + m * 16) * DM + cc);
                const f32x4 gv = *(const f32x4*)(gp + cc) * coef;
#pragma unroll
                for (int ai = 0; ai < 2; ++ai)
#pragma unroll
                    for (int m = 0; m < 4; ++m) *(f32x4*)(dst + (size_t)(r0 + ai * 128 + m * 16) * DM + cc) = xv[ai][m] + gv * acc[ai][bj][m][n];
            }
    }
};
struct EpiResid3 {
    static constexpr bool PERM = false;
    const float* xp; const float* xs; float* out; const float* gate; float coef; int pad_;
    DI void operator()(const f32x4 (&acc)[2][2][3][2], const Unit& u, int wr, int wc, int fr, int fq) const {
        asm volatile("" : "+v"(fr), "+v"(fq));
        const int rowt = u.pm * 192, rowb = rowt + wr * 48 + fr, col0 = u.pn * 256 + wc * 32 + 4 * fq;
        const int mr0 = mod_row(rowt);
        if (mr0 == mod_row(rowt + 191)) {
            const float* gp = gate + (size_t)mr0 * 9216;
            const float* src = rowt < MP ? xp : xs - (size_t)MP * DM;
#pragma unroll
            for (int bj = 0; bj < 2; ++bj)
#pragma unroll
                for (int n = 0; n < 2; ++n) {
                    const int cc = col0 + bj * 128 + n * 16;
                    f32x4 xv[2][3];
#pragma unroll
                    for (int ai = 0; ai < 2; ++ai)
#pragma unroll
                        for (int m = 0; m < 3; ++m) xv[ai][m] = *(const f32x4*)(src + (size_t)(rowb + ai * 96 + m * 16) * DM + cc);
                    const f32x4 gv = *(const f32x4*)(gp + cc) * coef;
#pragma unroll
                    for (int ai = 0; ai < 2; ++ai)
#pragma unroll
                        for (int m = 0; m < 3; ++m) *(f32x4*)(out + (size_t)(rowb + ai * 96 + m * 16) * DM + cc) = xv[ai][m] + gv * acc[ai][bj][m][n];
                }
        } else {
#pragma unroll
            for (int bj = 0; bj < 2; ++bj)
#pragma unroll
                for (int n = 0; n < 2; ++n) {
                    const int cc = col0 + bj * 128 + n * 16;
                    f32x4 xv[2][3], gv[2][3];
#pragma unroll
                    for (int ai = 0; ai < 2; ++ai)
#pragma unroll
                        for (int m = 0; m < 3; ++m) {
                            const int row = rowb + ai * 96 + m * 16;
                            const float* src = row < MP ? xp + (size_t)row * DM : xs + (size_t)(row - MP) * DM;
                            xv[ai][m] = *(const f32x4*)(src + cc);
                            gv[ai][m] = *(const f32x4*)(gate + (size_t)mod_row(row) * 9216 + cc);
                        }
#pragma unroll
                    for (int ai = 0; ai < 2; ++ai)
#pragma unroll
                        for (int m = 0; m < 3; ++m) {
                            const int row = rowb + ai * 96 + m * 16;
                            *(f32x4*)(out + (size_t)row * DM + cc) = xv[ai][m] + gv[ai][m] * coef * acc[ai][bj][m][n];
                        }
                }
        }
    }
};
struct EpiSplit {
    static constexpr bool PERM = true;
    bf16_t* b0; bf16_t* b1; bf16_t* b2; int ld0, ld1, ld2, n0, n1;
    DI void operator()(const f32x4 (&acc)[2][2][4][2], const Unit& u, int wr, int wc, int fr, int fq) const {
        asm volatile("" : "+v"(fr), "+v"(fq));
        bf16_t* base; int ld, ct;
        if (u.pn < n0) { base = b0; ld = ld0; ct = u.pn; } else if (u.pn < n0 + n1) { base = b1; ld = ld1; ct = u.pn - n0; } else { base = b2; ld = ld2; ct = u.pn - n0 - n1; }
        const int row0 = u.pm * 256 + wr * 64 + fr, col0 = ct * 256 + wc * 32 + 8 * fq;
#pragma unroll
        for (int ai = 0; ai < 2; ++ai)
#pragma unroll
            for (int m = 0; m < 4; ++m) {
                bf16_t* rowp = base + (size_t)(row0 + ai * 128 + m * 16) * ld + col0;
#pragma unroll
                for (int bj = 0; bj < 2; ++bj) {
                    u32x4 w; w.x = pack2(acc[ai][bj][m][0][0], acc[ai][bj][m][0][1]); w.y = pack2(acc[ai][bj][m][0][2], acc[ai][bj][m][0][3]);
                    w.z = pack2(acc[ai][bj][m][1][0], acc[ai][bj][m][1][1]); w.w = pack2(acc[ai][bj][m][1][2], acc[ai][bj][m][1][3]);
                    *(u32x4*)(rowp + bj * 128) = w;
                }
            }
    }
};
struct EpiGates {
    static constexpr bool PERM = false;
    const bf16_t* xc; _Float16* la; _Float16* uu; const float* ba; const float* bi; const float* lam;
    DI void operator()(const f32x4 (&acc)[2][2][4][2], const Unit& u, int wr, int wc, int fr, int fq) const {
        asm volatile("" : "+v"(fr), "+v"(fq));
        const int dir = u.pn >> 2, cgp = u.pn & 3;
        const int ch0 = cgp * 128 + wc * 32 + 4 * fq;
        _Float16* lad = la + (size_t)dir * MTOK * 512; _Float16* ud = uu + (size_t)dir * MTOK * 512;
#pragma unroll
        for (int n = 0; n < 2; ++n) {
            const int ch = ch0 + n * 16;
            float bav[4], biv[4], spv[4];
#pragma unroll
            for (int j = 0; j < 4; ++j) { const int cx = dir * 512 + ch + j; bav[j] = ba[cx]; biv[j] = bi[cx]; const float lm = lam[cx]; spv[j] = (lm < -15.f) ? -lm : log1pf(__expf(-lm)); }
            u32x2 xw[2][4];
#pragma unroll
            for (int ai = 0; ai < 2; ++ai)
#pragma unroll
                for (int m = 0; m < 4; ++m) xw[ai][m] = *(const u32x2*)(xc + (size_t)(u.pm * 256 + ai * 128 + wr * 64 + m * 16 + fr) * 512 + ch);
#pragma unroll
            for (int ai = 0; ai < 2; ++ai)
#pragma unroll
                for (int m = 0; m < 4; ++m) {
                    const size_t r = (size_t)(u.pm * 256 + ai * 128 + wr * 64 + m * 16 + fr);
                    const float xv[4] = {bflo(xw[ai][m].x), bfhi(xw[ai][m].x), bflo(xw[ai][m].y), bfhi(xw[ai][m].y)};
                    h16x4 lo, uo;
#pragma unroll
                    for (int j = 0; j < 4; ++j) {
                        const float rr = fsigmoid(acc[ai][0][m][n][j] + bav[j]), ii = fsigmoid(acc[ai][1][m][n][j] + biv[j]);
                        const float lg = -8.f * rr * spv[j];
                        lo[j] = (_Float16)lg; uo[j] = (_Float16)(ii * xv[j]);
                    }
                    *(h16x4*)(lad + r * 512 + ch) = lo; *(h16x4*)(ud + r * 512 + ch) = uo;
                }
        }
    }
};

template <class Epi>
DI void run_gemm(unsigned char* shm, const bf16_t* A, const bf16_t* Bt, int N, int K, const Epi& E) {
    pg8::StaticOrder S; S.init(MTOK, N, (int)gridDim.x, (int)blockIdx.x);
    pg8::gemm_phase<Epi, pg8::StaticOrder>((PG8_LAS unsigned char*)shm, pg8::Gemm{A, Bt, MTOK, N, K, 0, 0}, S, E);
}

DI void run_gemm_resid192(unsigned char* shm, const bf16_t* A, const bf16_t* Bt, int K, const EpiResid3& E) {
    pg8::StaticOrder S; S.init(MTOK, 1024, (int)gridDim.x, (int)blockIdx.x, 192);
    pg8::gemm_phase<EpiResid3, pg8::StaticOrder, 3>((PG8_LAS unsigned char*)shm, pg8::Gemm{A, Bt, MTOK, 1024, K, 0, 0}, S, E);
}

DI void transpose_tile(const float* __restrict__ src, int lds_, int k0, int n0, bf16_t* __restrict__ dst, int ldd, int drow0, int mode, float*) {
    const int tid = tidx(), lane = tid & 63, w = tid >> 6, kb = lane & 7, ng = lane >> 3;
    const int c = 32 * w + 4 * ng;
    const float* sp = src + (size_t)(k0 + 8 * kb) * lds_ + n0 + c;
    float4 v[8];
#pragma unroll
    for (int j = 0; j < 8; ++j) v[j] = *(const float4*)(sp + (size_t)j * lds_);
    const float x[4][8] = {{v[0].x, v[1].x, v[2].x, v[3].x, v[4].x, v[5].x, v[6].x, v[7].x}, {v[0].y, v[1].y, v[2].y, v[3].y, v[4].y, v[5].y, v[6].y, v[7].y},
                           {v[0].z, v[1].z, v[2].z, v[3].z, v[4].z, v[5].z, v[6].z, v[7].z}, {v[0].w, v[1].w, v[2].w, v[3].w, v[4].w, v[5].w, v[6].w, v[7].w}};
#pragma unroll
    for (int q = 0; q < 4; ++q) {
        const int cc = c + q;
        const int drow = mode ? drow0 + 256 * (cc >> 7) + (cc & 127) : drow0 + cc;
        *(u32x4*)(dst + (size_t)drow * ldd + k0 + 8 * kb) = pack8(x[q]);
    }
}

DI void phase_prep(const Params& p, unsigned char* shm) {
    const int tid = tidx();
    unsigned char* ws = p.ws;
    float* s_silu = (float*)shm;
    float* red = (float*)(shm + 36864);
    float* tile = (float*)(shm + 36864 + 18432);
    if (blockIdx.x == 0) for (int i = tid; i < (int)(CNT_BYTES / 4); i += 512) ((unsigned*)(ws + OFF_CNT))[i] = 0u;
    for (int i = tid; i < 9216; i += 512) { const int r = i >> 10, k = i & 1023; const float v = r == 0 ? p.c_ctx[k] : p.c[(r - 1) * 1024 + k]; s_silu[i] = silu_f(v); }
    __syncthreads();
    constexpr int N_MOD_IT = 576, N_TR = 2688, N_CK = 768, N_WG = 256;
    constexpr int TOTAL = N_MOD_IT + N_TR + N_CK + N_WG;
    float* modbuf = (float*)(ws + OFF_MOD);
    for (int item = blockIdx.x; item < TOTAL; item += gridDim.x) {
        if (item < N_MOD_IT) {
            const int l = item / 288, col0 = (item % 288) * 32, c = tid & 31, kg = tid >> 5;
            float acc[9];
#pragma unroll
            for (int r = 0; r < 9; ++r) acc[r] = 0.f;
            const float* wp = p.w_mod + (size_t)l * 1024 * 9216 + (size_t)(kg * 64) * 9216 + col0 + c;
            for (int k = 0; k < 64; k += 16) {
                float w[16];
#pragma unroll
                for (int q = 0; q < 16; ++q) w[q] = wp[(size_t)(k + q) * 9216];
#pragma unroll
                for (int q = 0; q < 16; ++q)
#pragma unroll
                    for (int r = 0; r < 9; ++r) acc[r] += s_silu[r * 1024 + kg * 64 + k + q] * w[q];
            }
#pragma unroll
            for (int r = 0; r < 9; ++r) red[(kg * 9 + r) * 32 + c] = acc[r];
            __syncthreads();
            if (tid < 288) {
                const int r = tid >> 5, cc = tid & 31; float sacc = 0.f;
#pragma unroll
                for (int g = 0; g < 16; ++g) sacc += red[(g * 9 + r) * 32 + cc];
                modbuf[(size_t)(l * 9 + r) * 9216 + col0 + cc] = sacc + p.b_mod[l * 9216 + col0 + cc];
            }
            __syncthreads();
        } else if (item < N_MOD_IT + N_TR) {
            int t = item - N_MOD_IT;
            if (t < 2112) {
                const int ls = t / 528, r = t % 528, which = r / 176, tt = r % 176;
                if (which < 2) {
                    const float* src = (which == 0 ? p.ffn_w1 : p.ffn_w3) + (size_t)ls * 1024 * DFF;
                    const int kt = tt / 11, n0 = (tt % 11) * 256;
                    transpose_tile(src, DFF, kt * 64, n0, (bf16_t*)(ws + OFF_W13 + ls * SZ_W13), 1024, 2 * n0 + which * 128, 1, tile);
                } else {
                    const float* src = p.ffn_w2 + (size_t)ls * DFF * 1024;
                    const int kt = tt / 4, n0 = (tt % 4) * 256;
                    transpose_tile(src, 1024, kt * 64, n0, (bf16_t*)(ws + OFF_W2 + ls * SZ_W2), DFF, n0, 0, tile);
                }
            } else if ((t -= 2112) < 160) { transpose_tile(p.e_w_in, 2560, (t / 10) * 64, (t % 10) * 256, (bf16_t*)(ws + OFF_EWIN), 1024, (t % 10) * 256, 0, tile); }
            else if ((t -= 160) < 64) { transpose_tile(p.e_w_out, 1024, (t / 4) * 64, (t % 4) * 256, (bf16_t*)(ws + OFF_EWOUT), 1024, (t % 4) * 256, 0, tile); }
            else if ((t -= 64) < 96) { transpose_tile(p.o_w_in, 1536, (t / 6) * 64, (t % 6) * 256, (bf16_t*)(ws + OFF_OWIN), 1024, (t % 6) * 256, 0, tile); }
            else if ((t -= 96) < 64) { transpose_tile(p.o_w_out, 1024, (t / 4) * 64, (t % 4) * 256, (bf16_t*)(ws + OFF_OWOUT), 1024, (t % 4) * 256, 0, tile); }
            else if ((t -= 64) < 128) {
                const int b = t / 16, r = t % 16;
                transpose_tile(p.cache_diff_v + (size_t)b * 512 * 512, 512, (r / 2) * 64, (r % 2) * 256, (bf16_t*)(ws + OFF_VDC), 512, b * 512 + (r % 2) * 256, 0, tile);
            } else { t -= 128;
                const int b = t / 8, r = t % 8;
                transpose_tile(p.cache_win_v + (size_t)b * 512 * 256, 256, r * 64, 0, (bf16_t*)(ws + OFF_VWC), 512, b * 256, 0, tile);
            }
        } else if (item < N_MOD_IT + N_TR + N_CK) {
            const int j = item - N_MOD_IT - N_TR;
            if (j < 512) {
                const int ch = j * 512 + tid, d8 = ch & 7, m = (ch >> 3) & 1, h = (ch >> 4) & 3, t = (ch >> 6) & 511, b = ch >> 15;
                const float* s = p.cache_diff_k + (size_t)ch * 8; float v[8];
                const float4 a = *(const float4*)s, bq = *(const float4*)(s + 4); v[0] = a.x; v[1] = a.y; v[2] = a.z; v[3] = a.w; v[4] = bq.x; v[5] = bq.y; v[6] = bq.z; v[7] = bq.w;
                *(u32x4*)((bf16_t*)(ws + OFF_KDC) + ((size_t)(((b * 4 + h) * 2 + m) * 512 + t)) * 64 + d8 * 8) = pack8(v);
            } else {
                const int ch = (j - 512) * 512 + tid, d8 = ch & 7, kv = (ch >> 3) & 3, t = (ch >> 5) & 511, b = ch >> 14;
                const float* s = p.cache_win_k + (size_t)ch * 8; float v[8];
                const float4 a = *(const float4*)s, bq = *(const float4*)(s + 4); v[0] = a.x; v[1] = a.y; v[2] = a.z; v[3] = a.w; v[4] = bq.x; v[5] = bq.y; v[6] = bq.z; v[7] = bq.w;
                *(u32x4*)((bf16_t*)(ws + OFF_KWC) + ((size_t)((b * 4 + kv) * 512 + t)) * 64 + d8 * 8) = pack8(v);
            }
        } else {
            const int j = item - N_MOD_IT - N_TR - N_CK;
            const int ch_ = j * 512 + tid, nrow = ch_ >> 6, k8 = (ch_ & 63) * 8;
            const int pn = nrow >> 8, bj = (nrow >> 7) & 1, cp = nrow & 127, dir = pn >> 2, ch = (pn & 3) * 128 + cp, n = ch >> 6, jj = ch & 63;
            float v[8];
#pragma unroll
            for (int q = 0; q < 8; ++q) v[q] = 0.f;
            if ((k8 >> 6) == n) {
                const float* W = (bj ? p.e_lru_wi : p.e_lru_wa) + (size_t)((dir * 8 + n) * 64 + (k8 & 63)) * 64 + jj;
#pragma unroll
                for (int q = 0; q < 8; ++q) v[q] = W[q * 64];
            }
            *(u32x4*)((bf16_t*)(ws + OFF_WG) + (size_t)nrow * 512 + k8) = pack8(v);
        }
    }
}

DI void phase_norm(const Params& p, int l, int which, bool first) {
    const int tid = tidx(), lane = tid & 63, wid = tid >> 6;
    const float* g = p.norm_g + (l * 3 + which) * DM;
    const float* modbuf = (const float*)(p.ws + OFF_MOD);
    bf16_t* H = (bf16_t*)(p.ws + P_H);
    auto issue = [&](int g4, float4 (&v)[4][4]) __attribute__((always_inline)) {
        const int row = g4 * 4;
        const float* xr = first ? (row < MP ? p.x_prompt + (size_t)row * DM : p.x_sample + (size_t)(row - MP) * DM) : p.out + (size_t)row * DM;
#pragma unroll
        for (int rr = 0; rr < 4; ++rr)
#pragma unroll
            for (int i = 0; i < 4; ++i) v[rr][i] = *(const float4*)(xr + (size_t)rr * DM + i * 256 + lane * 4);
    };
    float4 v[4][4], vn[4][4];
    if ((int)blockIdx.x * 8 + wid < MTOK / 4) issue((int)blockIdx.x * 8 + wid, v);
    for (int g4 = blockIdx.x * 8 + wid; g4 < MTOK / 4; g4 += gridDim.x * 8) {
        const int row = g4 * 4;
        const float* sh = modbuf + (size_t)(l * 9 + mod_row(row)) * 9216 + which * 3 * 1024;
        const float* sc = sh + 1024;
        const bool more = g4 + (int)gridDim.x * 8 < MTOK / 4;
        if (more) issue(g4 + (int)gridDim.x * 8, vn);
        float ss[4];
#pragma unroll
        for (int rr = 0; rr < 4; ++rr) ss[rr] = 0.f;
#pragma unroll
        for (int rr = 0; rr < 4; ++rr)
#pragma unroll
            for (int i = 0; i < 4; ++i) ss[rr] += v[rr][i].x * v[rr][i].x + v[rr][i].y * v[rr][i].y + v[rr][i].z * v[rr][i].z + v[rr][i].w * v[rr][i].w;
#pragma unroll
        for (int o = 32; o >= 1; o >>= 1) {
#pragma unroll
            for (int rr = 0; rr < 4; ++rr) ss[rr] += __shfl_xor(ss[rr], o);
        }
        float rs[4];
#pragma unroll
        for (int rr = 0; rr < 4; ++rr) rs[rr] = rsqrtf(ss[rr] * (1.f / 1024.f) + 1e-6f);
#pragma unroll
        for (int i = 0; i < 4; ++i) {
            const int col = i * 256 + lane * 4;
            const float4 g4v = *(const float4*)(g + col), s4 = *(const float4*)(sc + col), h4 = *(const float4*)(sh + col);
            const float mx = g4v.x * (1.f + s4.x), my = g4v.y * (1.f + s4.y), mz = g4v.z * (1.f + s4.z), mw = g4v.w * (1.f + s4.w);
#pragma unroll
            for (int rr = 0; rr < 4; ++rr) {
                u32x2 w;
                w.x = pack2(v[rr][i].x * rs[rr] * mx + h4.x, v[rr][i].y * rs[rr] * my + h4.y);
                w.y = pack2(v[rr][i].z * rs[rr] * mz + h4.z, v[rr][i].w * rs[rr] * mw + h4.w);
                *(u32x2*)(H + (size_t)(row + rr) * DM + col) = w;
            }
        }
        if (more) {
#pragma unroll
            for (int rr = 0; rr < 4; ++rr)
#pragma unroll
                for (int i = 0; i < 4; ++i) v[rr][i] = vn[rr][i];
        }
    }
}

DI void qk_norm_rope(float (&v)[8], const float* g8, bool rope, const float (&cs)[8], const float (&sn)[8], int lane) {
    float ss = 0.f;
#pragma unroll
    for (int j = 0; j < 8; ++j) ss += v[j] * v[j];
    ss += __shfl_xor(ss, 1); ss += __shfl_xor(ss, 2); ss += __shfl_xor(ss, 4);
    const float rs = rsqrtf(ss * (1.f / 64.f) + 1e-6f);
#pragma unroll
    for (int j = 0; j < 8; ++j) v[j] = v[j] * rs * g8[j];
    float pv[8];
#pragma unroll
    for (int j = 0; j < 8; ++j) pv[j] = __shfl_xor(v[j], 2);
    if (rope) {
        const bool lowhalf = ((lane & 2) == 0);
#pragma unroll
        for (int j = 0; j < 8; ++j) v[j] = lowhalf ? (v[j] * cs[j] - pv[j] * sn[j]) : (v[j] * cs[j] + pv[j] * sn[j]);
    }
}
DI void rope_table_fill(float* T) {
    for (int idx = tidx(); idx < 1024; idx += 512) {
        const int pos = idx >> 4, fi = idx & 15;
        const float inv = exp2f(-(float)(2 * fi) * (13.287712379549449f / 32.f));
        float sv, cv; sincosf((float)pos * inv, &sv, &cv);
        T[idx * 2] = cv; T[idx * 2 + 1] = sv;
    }
    __syncthreads();
}
DI void rope_tables(const float* T, int s, int lane, float (&cs)[8], float (&sn)[8]) {
    const int d0 = (lane & 7) * 8;
    const int pos = (d0 < 32) ? (s >> 6) : (s & 63);
    const float4* tp = (const float4*)(T + ((pos << 4) + (d0 & 15)) * 2);
#pragma unroll
    for (int j = 0; j < 4; ++j) { const float4 v = tp[j]; cs[2 * j] = v.x; sn[2 * j] = v.y; cs[2 * j + 1] = v.z; sn[2 * j + 1] = v.w; }
}
DI void ld8(const bf16_t* p, float (&v)[8]) { unpack8(*(const u32x4*)p, v); }
DI void st8f(float* p, const float (&v)[8]) { *(float4*)p = make_float4(v[0], v[1], v[2], v[3]); *(float4*)(p + 4) = make_float4(v[4], v[5], v[6], v[7]); }

DI void phase_post_even(const Params& p, unsigned char* shm) {
    const int tid = tidx(), lane = tid & 63, wid = tid >> 6;
    unsigned char* ws = p.ws;
    const bf16_t* XR = (const bf16_t*)(ws + P_XR); const bf16_t* QKV = (const bf16_t*)(ws + P_QKV);
    bf16_t* Qd = (bf16_t*)(ws + P_ATT); bf16_t* Kd = (bf16_t*)(ws + P_ATT + 24 * MiB); bf16_t* Vtd = (bf16_t*)(ws + P_ATT + 48 * MiB);
    bf16_t* xc = (bf16_t*)(ws + P_H);
    float* o_dk = p.out + (size_t)MTOK * DM; float* o_dv = o_dk + (size_t)MP * 512;
    bf16_t* svt = (bf16_t*)shm;
    float* ropeT = (float*)(shm + 16384); rope_table_fill(ropeT);
    float gq[8], gk[8], cw[4][8], cb[8];
#pragma unroll
    for (int j = 0; j < 8; ++j) { gq[j] = p.e_q_g[(lane & 7) * 8 + j]; gk[j] = p.e_k_g[(lane & 7) * 8 + j]; cb[j] = p.e_conv_b[lane * 8 + j];
#pragma unroll
        for (int t = 0; t < 4; ++t) cw[t][j] = p.e_conv_w[t * 512 + lane * 8 + j]; }
    auto issue = [&](int it, u32x4& wq, u32x4& wk, u32x4& wv, u32x4 (&wx)[4]) __attribute__((always_inline)) {
        const int row = it * 8 + wid; const bool prm = row < MP; const int S = prm ? 256 : 2048, s = prm ? (row & 255) : ((row - MP) & 2047);
        const bf16_t* zr = QKV + (size_t)row * 1536;
        wq = *(const u32x4*)(zr + lane * 8); wk = *(const u32x4*)(zr + 512 + lane * 8); wv = *(const u32x4*)(zr + 1024 + lane * 8);
#pragma unroll
        for (int t = 0; t < 4; ++t) { const int sp = s + t - 2; const int rr = (sp >= 0 && sp < S) ? row + t - 2 : row; wx[t] = *(const u32x4*)(XR + (size_t)rr * 512 + lane * 8); }
    };
    u32x4 wq, wk, wv, wx[4];
    if ((int)blockIdx.x < MTOK / 8) issue((int)blockIdx.x, wq, wk, wv, wx);
    for (int it = blockIdx.x; it < MTOK / 8; it += gridDim.x) {
        const int row = it * 8 + wid;
        const bool prm = row < MP;
        const int S = prm ? 256 : 2048, tok0 = prm ? 0 : MP;
        const int b = prm ? (row >> 8) : ((row - MP) >> 11), s = prm ? (row & 255) : ((row - MP) & 2047);
        u32x4 nq = wq, nk = wk, nv = wv, nx[4] = {wx[0], wx[1], wx[2], wx[3]};
        if (it + (int)gridDim.x < MTOK / 8) issue(it + (int)gridDim.x, nq, nk, nv, nx);
        float cs[8], sn[8];
        if (!prm) rope_tables(ropeT, s, lane, cs, sn);
        else {
#pragma unroll
            for (int j = 0; j < 8; ++j) { cs[j] = 1.f; sn[j] = 0.f; }
        }
        float v[8];
        unpack8(wq, v); qk_norm_rope(v, gq, !prm, cs, sn, lane);
#pragma unroll
        for (int j = 0; j < 8; ++j) v[j] *= 0.125f * LOG2E;
        *(u32x4*)(Qd + ((size_t)tok0 * 8 + (size_t)(b * 8 + (lane >> 3)) * S + s) * 64 + (lane & 7) * 8) = pack8(v);
        unpack8(wk, v);
        if (prm) { float ss = 0.f;
#pragma unroll
            for (int j = 0; j < 8; ++j) ss += v[j] * v[j];
            ss += __shfl_xor(ss, 1); ss += __shfl_xor(ss, 2); ss += __shfl_xor(ss, 4);
            const float rs = rsqrtf(ss * (1.f / 64.f) + 1e-6f); float o[8];
#pragma unroll
            for (int j = 0; j < 8; ++j) o[j] = v[j] * rs * gk[j];
            st8f(o_dk + (size_t)row * 512 + lane * 8, o);
        }
        qk_norm_rope(v, gk, !prm, cs, sn, lane);
        *(u32x4*)(Kd + ((size_t)tok0 * 8 + (size_t)(b * 8 + (lane >> 3)) * S + s) * 64 + (lane & 7) * 8) = pack8(v);
        {
            const u32x4 w = wv;
            unpack8(w, v);
            if (prm) st8f(o_dv + (size_t)row * 512 + lane * 8, v);
            const bf16_t e[8] = {(bf16_t)(w.x & 0xffff), (bf16_t)(w.x >> 16), (bf16_t)(w.y & 0xffff), (bf16_t)(w.y >> 16), (bf16_t)(w.z & 0xffff), (bf16_t)(w.z >> 16), (bf16_t)(w.w & 0xffff), (bf16_t)(w.w >> 16)};
#pragma unroll
            for (int j = 0; j < 8; ++j) svt[(lane * 8 + j) * 8 + wid] = e[j];
        }
        {
            float a[8];
#pragma unroll
            for (int j = 0; j < 8; ++j) a[j] = cb[j];
#pragma unroll
            for (int t = 0; t < 4; ++t) {
                const int sp = s + t - 2;
                if (sp >= 0 && sp < S) { float x[8]; unpack8(wx[t], x);
#pragma unroll
                    for (int j = 0; j < 8; ++j) a[j] += x[j] * cw[t][j]; }
            }
            *(u32x4*)(xc + (size_t)row * 512 + lane * 8) = pack8(a);
        }
        __syncthreads();
        {
            const int row0 = it * 8, s0 = prm ? (row0 & 255) : ((row0 - MP) & 2047), b0 = prm ? (row0 >> 8) : ((row0 - MP) >> 11);
            const int S0 = prm ? 256 : 2048; const size_t t0 = prm ? 0 : (size_t)MP * 512;
            *(u32x4*)(Vtd + t0 + ((size_t)b0 * 512 + tid) * S0 + s0) = *(const u32x4*)(svt + tid * 8);
        }
        __syncthreads();
        wq = nq; wk = nk; wv = nv; wx[0] = nx[0]; wx[1] = nx[1]; wx[2] = nx[2]; wx[3] = nx[3];
    }
}

DI void phase_post_odd(const Params& p, unsigned char* shm) {
    const int tid = tidx(), lane = tid & 63, wid = tid >> 6;
    unsigned char* ws = p.ws;
    const bf16_t* QKV = (const bf16_t*)(ws + P_QKV);
    bf16_t* Qw = (bf16_t*)(ws + P_ATT); bf16_t* Kw = (bf16_t*)(ws + P_ATT + 48 * MiB); bf16_t* Vtw = (bf16_t*)(ws + P_ATT + 60 * MiB);
    float* o_wk = p.out + (size_t)MTOK * DM + (size_t)2 * MP * 512 + 32768; float* o_wv = o_wk + (size_t)MP * 256;
    bf16_t* svt = (bf16_t*)shm;
    float* ropeT = (float*)(shm + 16384); rope_table_fill(ropeT);
    float gq[8], gk[8];
#pragma unroll
    for (int j = 0; j < 8; ++j) { gq[j] = p.o_q_g[(lane & 7) * 8 + j]; gk[j] = p.o_k_g[(lane & 7) * 8 + j]; }
    u32x4 pw0 = {0u, 0u, 0u, 0u}, pw1 = pw0, pw2 = pw0;
    if ((int)blockIdx.x < MTOK / 8) { const bf16_t* zn = QKV + (size_t)((int)blockIdx.x * 8 + wid) * 1536; pw0 = *(const u32x4*)(zn + lane * 8); pw1 = *(const u32x4*)(zn + 512 + lane * 8); pw2 = *(const u32x4*)(zn + 1024 + lane * 8); }
    for (int it = blockIdx.x; it < MTOK / 8; it += gridDim.x) {
        const int row = it * 8 + wid;
        const bool prm = row < MP;
        const int S = prm ? 256 : 2048, tok0 = prm ? 0 : MP;
        const int b = prm ? (row >> 8) : ((row - MP) >> 11), s = prm ? (row & 255) : ((row - MP) & 2047);
        float cs[8], sn[8];
        if (!prm) rope_tables(ropeT, s, lane, cs, sn);
        else {
#pragma unroll
            for (int j = 0; j < 8; ++j) { cs[j] = 1.f; sn[j] = 0.f; }
        }
        const u32x4 wq2[2] = {pw0, pw1};
        const u32x4 wkv = pw2;
        if (it + (int)gridDim.x < MTOK / 8) { const bf16_t* zn = QKV + (size_t)((it + (int)gridDim.x) * 8 + wid) * 1536; pw0 = *(const u32x4*)(zn + lane * 8); pw1 = *(const u32x4*)(zn + 512 + lane * 8); pw2 = *(const u32x4*)(zn + 1024 + lane * 8); }
        float v[8];
#pragma unroll
        for (int ps = 0; ps < 2; ++ps) {
            unpack8(wq2[ps], v); qk_norm_rope(v, gq, !prm, cs, sn, lane);
#pragma unroll
            for (int j = 0; j < 8; ++j) v[j] *= 0.125f * LOG2E;
            const int head = ps * 8 + (lane >> 3);
            *(u32x4*)(Qw + ((size_t)tok0 * 16 + (size_t)(b * 16 + head) * S + s) * 64 + (lane & 7) * 8) = pack8(v);
        }
        const u32x4 w = wkv;
        unpack8(w, v);
        if (lane >= 32) {
            if (prm) st8f(o_wv + (size_t)row * 256 + (lane - 32) * 8, v);
            const bf16_t e[8] = {(bf16_t)(w.x & 0xffff), (bf16_t)(w.x >> 16), (bf16_t)(w.y & 0xffff), (bf16_t)(w.y >> 16), (bf16_t)(w.z & 0xffff), (bf16_t)(w.z >> 16), (bf16_t)(w.w & 0xffff), (bf16_t)(w.w >> 16)};
#pragma unroll
            for (int j = 0; j < 8; ++j) svt[((lane - 32) * 8 + j) * 8 + wid] = e[j];
        }
        {
            float ss = 0.f;
#pragma unroll
            for (int j = 0; j < 8; ++j) ss += v[j] * v[j];
            ss += __shfl_xor(ss, 1); ss += __shfl_xor(ss, 2); ss += __shfl_xor(ss, 4);
            const float rs = rsqrtf(ss * (1.f / 64.f) + 1e-6f);
            if (prm && lane < 32) { float o[8];
#pragma unroll
                for (int j = 0; j < 8; ++j) o[j] = v[j] * rs * gk[j];
                st8f(o_wk + (size_t)row * 256 + lane * 8, o); }
        }
        qk_norm_rope(v, gk, !prm, cs, sn, lane);
        if (lane < 32) *(u32x4*)(Kw + ((size_t)tok0 * 4 + (size_t)(b * 4 + (lane >> 3)) * S + s) * 64 + (lane & 7) * 8) = pack8(v);
        __syncthreads();
        if (tid < 256) {
            const int row0 = it * 8, s0 = prm ? (row0 & 255) : ((row0 - MP) & 2047), b0 = prm ? (row0 >> 8) : ((row0 - MP) >> 11);
            const int S0 = prm ? 256 : 2048; const size_t t0 = prm ? 0 : (size_t)MP * 256;
            *(u32x4*)(Vtw + t0 + ((size_t)b0 * 256 + tid) * S0 + s0) = *(const u32x4*)(svt + tid * 8);
        }
        __syncthreads();
    }
}

template <int BATCH>
DI void scan_item(const Params& p, unsigned char* shm, bool prm, int b, int cgi) {
    const int tid = tidx(), l16 = tid & 15, chunk = tid >> 4;
    unsigned char* ws = p.ws;
    const int S = prm ? 256 : 2048, tok0 = prm ? b * 256 : MP + b * 2048, Lc = S >> 5;
    const int ch = cgi * 64 + l16 * 4;
    const bf16_t* GT = (const bf16_t*)(ws + P_GT);
    bf16_t* Aout = (bf16_t*)(ws + P_H);
    float* sA = (float*)shm; float* sB = sA + 2048;
    float* o_st = p.out + (size_t)MTOK * DM + (size_t)2 * MP * 512;
#pragma unroll
    for (int dir = 0; dir < 2; ++dir) {
        const _Float16* LA = (const _Float16*)(ws + P_LAU) + (size_t)dir * MTOK * 512;
        const _Float16* UU = (const _Float16*)(ws + P_LAU + 48 * MiB) + (size_t)dir * MTOK * 512;
        float A[4] = {1.f, 1.f, 1.f, 1.f}, B[4] = {0.f, 0.f, 0.f, 0.f};
        for (int i0 = 0; i0 < Lc; i0 += BATCH) {
            h16x4 av[BATCH], uv[BATCH];
#pragma unroll
            for (int q = 0; q < BATCH; ++q) { const int pos = dir == 0 ? chunk * Lc + i0 + q : S - 1 - (chunk * Lc + i0 + q); const size_t idx = (size_t)(tok0 + pos) * 512 + ch; av[q] = *(const h16x4*)(LA + idx); uv[q] = *(const h16x4*)(UU + idx); }
#pragma unroll
            for (int q = 0; q < BATCH; ++q)
#pragma unroll
                for (int j = 0; j < 4; ++j) { const float e = __builtin_amdgcn_exp2f((float)av[q][j] * LOG2E); B[j] = e * B[j] + __builtin_amdgcn_sqrtf(fmaxf(1.f - e * e, 0.f)) * (float)uv[q][j]; A[j] *= e; }
        }
        *(float4*)(sA + chunk * 64 + l16 * 4) = make_float4(A[0], A[1], A[2], A[3]);
        *(float4*)(sB + chunk * 64 + l16 * 4) = make_float4(B[0], B[1], B[2], B[3]);
        __syncthreads();
        float hh[4];
#pragma unroll
        for (int j = 0; j < 4; ++j) hh[j] = prm ? 0.f : p.state_lru[(size_t)(b * 2 + dir) * 512 + ch + j];
        for (int cc = 0; cc < chunk; ++cc) {
            const float4 a4 = *(const float4*)(sA + cc * 64 + l16 * 4), b4 = *(const float4*)(sB + cc * 64 + l16 * 4);
            hh[0] = a4.x * hh[0] + b4.x; hh[1] = a4.y * hh[1] + b4.y; hh[2] = a4.z * hh[2] + b4.z; hh[3] = a4.w * hh[3] + b4.w;
        }
        for (int i0 = 0; i0 < Lc; i0 += BATCH) {
            h16x4 av[BATCH], uv[BATCH]; u32x2 gv[BATCH], hv[BATCH];
#pragma unroll
            for (int q = 0; q < BATCH; ++q) { const int pos = dir == 0 ? chunk * Lc + i0 + q : S - 1 - (chunk * Lc + i0 + q); const size_t t = (size_t)(tok0 + pos); av[q] = *(const h16x4*)(LA + t * 512 + ch); uv[q] = *(const h16x4*)(UU + t * 512 + ch);
                if (dir == 1) { gv[q] = *(const u32x2*)(GT + t * 512 + ch); hv[q] = *(const u32x2*)(Aout + t * 1024 + ch); } }
#pragma unroll
            for (int q = 0; q < BATCH; ++q) {
                const int pos = dir == 0 ? chunk * Lc + i0 + q : S - 1 - (chunk * Lc + i0 + q); const size_t t = (size_t)(tok0 + pos);
                float o[4];
#pragma unroll
                for (int j = 0; j < 4; ++j) { const float e = __builtin_amdgcn_exp2f((float)av[q][j] * LOG2E); hh[j] = e * hh[j] + __builtin_amdgcn_sqrtf(fmaxf(1.f - e * e, 0.f)) * (float)uv[q][j]; o[j] = hh[j]; }
                if (dir == 1) {
                    const float g[4] = {bflo(gv[q].x), bfhi(gv[q].x), bflo(gv[q].y), bfhi(gv[q].y)}, hf[4] = {bflo(hv[q].x), bfhi(hv[q].x), bflo(hv[q].y), bfhi(hv[q].y)};
#pragma unroll
                    for (int j = 0; j < 4; ++j) { const float x = g[j]; const float u2 = 1.5957691216057308f * (x + 0.044715f * x * x * x); o[j] = (hf[j] + hh[j]) * x * fsigmoid(u2); }
                }
                u32x2 w; w.x = pack2(o[0], o[1]); w.y = pack2(o[2], o[3]);
                *(u32x2*)(Aout + t * 1024 + ch) = w;
            }
        }
        if (prm && chunk == 31) {
#pragma unroll
            for (int j = 0; j < 4; ++j) o_st[(size_t)(b * 2 + dir) * 512 + ch + j] = hh[j];
        }
        __syncthreads();
    }
}

struct AttnSeg { const bf16_t* K0; const bf16_t* K1; const bf16_t* Vt; int ldv, kt0, nt; };
#define MFMA32(a, b, c) __builtin_amdgcn_mfma_f32_32x32x16_bf16((a), (b), (c), 0, 0, 0)

template <int NKB, int DV>
DI void attn_load(const AttnSeg& sg, int kt, u32x4 (&kr)[NKB], u32x4 (&vr)[DV / 64]) {
    const int tid = tidx(), key = tid >> 3, part = tid & 7;
    kr[0] = *(const u32x4*)(sg.K0 + (size_t)(kt * 64 + key) * 64 + part * 8);
    if (NKB == 2) kr[NKB - 1] = *(const u32x4*)(sg.K1 + (size_t)(kt * 64 + key) * 64 + part * 8);
#pragma unroll
    for (int i = 0; i < DV / 64; ++i) { const int c = tid + i * 512, e = c >> 3, pt = c & 7; vr[i] = *(const u32x4*)(sg.Vt + (size_t)e * sg.ldv + kt * 64 + pt * 8); }
}
template <int NKB, int DV>
DI void attn_store(unsigned char* buf, const u32x4 (&kr)[NKB], const u32x4 (&vr)[DV / 64]) {
    const int tid = tidx(), key = tid >> 3, part = tid & 7;
#pragma unroll
    for (int nb = 0; nb < NKB; ++nb) *(u32x4*)(buf + nb * (64 * 144) + key * 144 + part * 16) = kr[nb];
#pragma unroll
    for (int i = 0; i < DV / 64; ++i) { const int c = tid + i * 512, e = c >> 3, pt = c & 7; *(u32x4*)(buf + NKB * (64 * 144) + e * 144 + pt * 16) = vr[i]; }
}

template <int NKB, int DV, bool WIN>
DI void attn_run(unsigned char* shm, const AttnSeg& s0, const AttnSeg& s1, const bf16_t* Qmat, int qrow0, int kb, bool mask1, float m_init, float l_init,
                 f32x16 (&O)[DV / 32], float& l_out) {
    constexpr int BUF = (NKB * 64 + DV) * 144;
    const int lane = tidx() & 63, r = lane & 31, h = lane >> 5;
    const int pr = (r & ~12) | ((r & 4) << 1) | ((r & 8) >> 1);
    bf16x8 qf[4];
#pragma unroll
    for (int s = 0; s < 4; ++s) qf[s] = *(const bf16x8*)(Qmat + (size_t)(qrow0 + r) * 64 + 16 * s + 8 * h);
#pragma unroll
    for (int et = 0; et < DV / 32; ++et)
#pragma unroll
        for (int i = 0; i < 16; ++i) O[et][i] = 0.f;
    float m = m_init, l = l_init;
    const int ntot = s0.nt + s1.nt;
    u32x4 krA[NKB], vrA[DV / 64], krB[NKB], vrB[DV / 64];
    auto load_tile = [&](int t, u32x4 (&kr)[NKB], u32x4 (&vr)[DV / 64]) __attribute__((always_inline)) {
        if (t < ntot) { if (t < s0.nt) attn_load<NKB, DV>(s0, s0.kt0 + t, kr, vr); else attn_load<NKB, DV>(s1, s1.kt0 + (t - s0.nt), kr, vr); }
    };
    auto compute_tile = [&](int t, const unsigned char* buf) __attribute__((always_inline)) {
        const bool inseg1 = t >= s0.nt;
        const int kpos0 = inseg1 ? (s1.kt0 + t - s0.nt) * 64 : 0;
        const bool masked = WIN && mask1 && inseg1;
        bool skip = false;
        if (masked) skip = (kpos0 > qrow0 + 31 + 128) || (kpos0 + 63 < qrow0 - 128);
        if (!skip) {
            const unsigned char* kbuf = buf + kb * (64 * 144);
            f32x16 st0, st1;
#pragma unroll
            for (int i = 0; i < 16; ++i) { st0[i] = 0.f; st1[i] = 0.f; }
            const unsigned char* vbuf = buf + NKB * (64 * 144);
            bf16x8 kf[8], vf[2][4];
#pragma unroll
            for (int s = 0; s < 4; ++s) {
                kf[2 * s] = *(const bf16x8*)(kbuf + pr * 144 + (16 * s + 8 * h) * 2);
                kf[2 * s + 1] = *(const bf16x8*)(kbuf + (32 + pr) * 144 + (16 * s + 8 * h) * 2);
            }
            __builtin_amdgcn_sched_barrier(0);
            __builtin_amdgcn_s_setprio(1);
#pragma unroll
            for (int s = 0; s < 4; ++s) { st0 = MFMA32(kf[2 * s], qf[s], st0); st1 = MFMA32(kf[2 * s + 1], qf[s], st1); }
            __builtin_amdgcn_s_setprio(0);
#pragma unroll
            for (int f = 0; f < 4; ++f)
                vf[0][f] = *(const bf16x8*)(vbuf + (32 * (f >> 2) + r) * 144 + (32 * ((f >> 1) & 1) + 16 * (f & 1) + 8 * h) * 2);
            __builtin_amdgcn_sched_barrier(0);
            if (masked) {
                const int qp = qrow0 + r;
#pragma unroll
                for (int i = 0; i < 16; ++i) {
                    const int kp = kpos0 + (i & 7) + 8 * h + 16 * (i >> 3);
                    int d0 = qp - kp; d0 = d0 < 0 ? -d0 : d0; int d1 = qp - (kp + 32); d1 = d1 < 0 ? -d1 : d1;
                    if (d0 > 128) st0[i] = -1e30f;
                    if (d1 > 128) st1[i] = -1e30f;
                }
            }
            float mx = fmaxf(st0[0], st1[0]);
#pragma unroll
            for (int i = 1; i < 16; ++i) mx = fmaxf(mx, fmaxf(st0[i], st1[i]));
            mx = xhalf_max(mx);
            const float mn = fmaxf(m, mx);
            if (__any(mn > m + 8.f)) {
                const float alpha = __builtin_amdgcn_exp2f(m - mn);
                l *= alpha;
#pragma unroll
                for (int et = 0; et < DV / 32; ++et)
#pragma unroll
                    for (int i = 0; i < 16; ++i) O[et][i] *= alpha;
                m = mn;
            }
            float ps = 0.f;
#pragma unroll
            for (int i = 0; i < 16; ++i) { st0[i] = __builtin_amdgcn_exp2f(st0[i] - m); st1[i] = __builtin_amdgcn_exp2f(st1[i] - m); ps += st0[i] + st1[i]; }
            l += ps;
            bf16x8 pf[2][2];
#pragma unroll
            for (int s2 = 0; s2 < 2; ++s2) {
                u32x4 w0, w1;
                w0.x = pack2(st0[8 * s2 + 0], st0[8 * s2 + 1]); w0.y = pack2(st0[8 * s2 + 2], st0[8 * s2 + 3]); w0.z = pack2(st0[8 * s2 + 4], st0[8 * s2 + 5]); w0.w = pack2(st0[8 * s2 + 6], st0[8 * s2 + 7]);
                w1.x = pack2(st1[8 * s2 + 0], st1[8 * s2 + 1]); w1.y = pack2(st1[8 * s2 + 2], st1[8 * s2 + 3]); w1.z = pack2(st1[8 * s2 + 4], st1[8 * s2 + 5]); w1.w = pack2(st1[8 * s2 + 6], st1[8 * s2 + 7]);
                pf[0][s2] = __builtin_bit_cast(bf16x8, w0); pf[1][s2] = __builtin_bit_cast(bf16x8, w1);
            }
#pragma unroll
            for (int b = 0; b < DV / 32; ++b) {
                if (b + 1 < DV / 32) {
#pragma unroll
                    for (int f = 0; f < 4; ++f)
                        vf[(b + 1) & 1][f] = *(const bf16x8*)(vbuf + (32 * (b + 1) + r) * 144 + (32 * ((f >> 1) & 1) + 16 * (f & 1) + 8 * h) * 2);
                }
                __builtin_amdgcn_sched_barrier(0);
                __builtin_amdgcn_s_setprio(1);
#pragma unroll
                for (int f = 0; f < 4; ++f) O[b] = MFMA32(vf[b & 1][f], pf[(f >> 1) & 1][f & 1], O[b]);
                __builtin_amdgcn_s_setprio(0);
                __builtin_amdgcn_sched_barrier(0);
            }
        }
    };
    load_tile(0, krA, vrA); load_tile(1, krB, vrB);
    attn_store<NKB, DV>(shm, krA, vrA);
    __syncthreads();
    load_tile(2, krA, vrA);
    for (int t = 0; t < ntot; t += 2) {
        compute_tile(t, shm);
        attn_store<NKB, DV>(shm + BUF, krB, vrB);
        __syncthreads();
        load_tile(t + 3, krB, vrB);
        compute_tile(t + 1, shm + BUF);
        if (t + 2 < ntot) attn_store<NKB, DV>(shm, krA, vrA);
        __syncthreads();
        load_tile(t + 4, krA, vrA);
    }
    l_out = l + __shfl_xor(l, 32);
}

DI void diff_attn_item(const Params& p, unsigned char* shm, bool prm, int b, int hd, int qblk, float lam) {
    unsigned char* ws = p.ws;
    const int tid = tidx(), lane = tid & 63, wid = tid >> 6, r = lane & 31, h = lane >> 5;
    const int pair = wid >> 1, kb = wid & 1;
    const int S = prm ? 256 : 2048; const size_t tok0 = prm ? 0 : MP;
    const bf16_t* Qd = (const bf16_t*)(ws + P_ATT); const bf16_t* Kd = (const bf16_t*)(ws + P_ATT + 24 * MiB); const bf16_t* Vtd = (const bf16_t*)(ws + P_ATT + 48 * MiB);
    bf16_t* Aout = (bf16_t*)(ws + P_H);
    AttnSeg s0, s1;
    s0.K0 = (const bf16_t*)(ws + OFF_KDC) + (size_t)((b * 4 + hd) * 2) * 512 * 64; s0.K1 = s0.K0 + 512 * 64;
    s0.Vt = (const bf16_t*)(ws + OFF_VDC) + (size_t)(b * 512 + hd * 128) * 512; s0.ldv = 512; s0.kt0 = 0; s0.nt = prm ? 0 : 8;
    s1.K0 = Kd + (tok0 * 8 + (size_t)((b * 4 + hd) * 2) * S) * 64; s1.K1 = s1.K0 + (size_t)S * 64;
    s1.Vt = Vtd + tok0 * 512 + (size_t)(b * 512 + hd * 128) * S; s1.ldv = S; s1.kt0 = 0; s1.nt = S / 64;
    const bf16_t* Qmat = Qd + (tok0 * 8 + (size_t)((b * 4 + hd) * 2 + kb) * S) * 64;
    const int qrow0 = qblk * 128 + pair * 32;
    f32x16 O[4]; float lt;
    attn_run<2, 128, false>(shm, s0, s1, Qmat, qrow0, kb, false, -1e30f, 0.f, O, lt);
    const float inv = 1.f / lt;
    float* X = (float*)shm + pair * 4096;
    if (kb == 1) {
#pragma unroll
        for (int et = 0; et < 4; ++et)
#pragma unroll
            for (int i = 0; i < 16; ++i) X[(et * 16 + i) * 64 + lane] = O[et][i] * inv;
    }
    __syncthreads();
    if (kb == 0) {
        float ss = 0.f;
#pragma unroll
        for (int et = 0; et < 4; ++et)
#pragma unroll
            for (int i = 0; i < 16; ++i) { const float o = O[et][i] * inv - lam * X[(et * 16 + i) * 64 + lane]; O[et][i] = o; ss += o * o; }
        ss += __shfl_xor(ss, 32);
        const float rs = rsqrtf(ss * (1.f / 128.f) + 1e-6f) * 0.8f;
        const size_t row = (size_t)(prm ? b * 256 : MP + b * 2048) + qrow0 + r;
        bf16_t* op = Aout + row * 1024 + 512 + hd * 128;
#pragma unroll
        for (int et = 0; et < 4; ++et)
#pragma unroll
            for (int g = 0; g < 4; ++g) {
                const int e = 32 * et + 8 * g + 4 * h;
                const float4 sg = *(const float4*)(p.e_subln_g + e);
                u32x2 w; w.x = pack2(O[et][4 * g + 0] * rs * sg.x, O[et][4 * g + 1] * rs * sg.y); w.y = pack2(O[et][4 * g + 2] * rs * sg.z, O[et][4 * g + 3] * rs * sg.w);
                *(u32x2*)(op + e) = w;
            }
    }
    __syncthreads();
}

DI void win_attn_item(const Params& p, unsigned char* shm, bool prm, int b, int head, int qblk) {
    unsigned char* ws = p.ws;
    const int tid = tidx(), lane = tid & 63, wid = tid >> 6, r = lane & 31, h = lane >> 5;
    const int S = prm ? 256 : 2048; const size_t tok0 = prm ? 0 : MP; const int kv = head >> 2;
    const bf16_t* Qw = (const bf16_t*)(ws + P_ATT); const bf16_t* Kw = (const bf16_t*)(ws + P_ATT + 48 * MiB); const bf16_t* Vtw = (const bf16_t*)(ws + P_ATT + 60 * MiB);
    bf16_t* Aout = (bf16_t*)(ws + P_H);
    const int q0 = qblk * 256;
    AttnSeg s0, s1;
    s0.K0 = (const bf16_t*)(ws + OFF_KWC) + (size_t)(b * 4 + kv) * 512 * 64; s0.K1 = s0.K0;
    s0.Vt = (const bf16_t*)(ws + OFF_VWC) + (size_t)(b * 256 + kv * 64) * 512; s0.ldv = 512; s0.kt0 = 0; s0.nt = prm ? 0 : 8;
    s1.K0 = Kw + (tok0 * 4 + (size_t)(b * 4 + kv) * S) * 64; s1.K1 = s1.K0;
    s1.Vt = Vtw + tok0 * 256 + (size_t)(b * 256 + kv * 64) * S; s1.ldv = S;
    if (prm) { s1.kt0 = 0; s1.nt = 4; }
    else { const int lo = (q0 - 128 < 0 ? 0 : q0 - 128) >> 6, hi = (q0 + 384 > S ? S : q0 + 384) >> 6; s1.kt0 = lo; s1.nt = hi - lo; }
    const bf16_t* Qmat = Qw + (tok0 * 16 + (size_t)(b * 16 + head) * S) * 64;
    const int qrow0 = q0 + wid * 32;
    f32x16 O[2]; float lt;
    attn_run<1, 64, true>(shm, s0, s1, Qmat, qrow0, 0, !prm, p.o_sink[head] * LOG2E, h == 0 ? 1.f : 0.f, O, lt);
    const float inv = 1.f / lt;
    const size_t row = (size_t)(prm ? b * 256 : MP + b * 2048) + qrow0 + r;
    bf16_t* op = Aout + row * 1024 + head * 64;
#pragma unroll
    for (int et = 0; et < 2; ++et)
#pragma unroll
        for (int g = 0; g < 4; ++g) {
            const int e = 32 * et + 8 * g + 4 * h;
            u32x2 w; w.x = pack2(O[et][4 * g + 0] * inv, O[et][4 * g + 1] * inv); w.y = pack2(O[et][4 * g + 2] * inv, O[et][4 * g + 3] * inv);
            *(u32x2*)(op + e) = w;
        }
}

DI int pop_item(unsigned char* shm, unsigned* counter) {
    int* slot = (int*)(shm + LDS_BYTES + 16);
    if (tidx() == 0) *slot = (int)atomicAdd(counter, 1u);
    __syncthreads();
    const int it = *slot;
    __syncthreads();
    return it;
}
DI unsigned queues_left(unsigned char* shm, unsigned* counters, unsigned limit) {
    int* fl = (int*)(shm + LDS_BYTES + 32);
    const int tid = tidx();
    if (tid < 8) fl[tid] = __hip_atomic_load(counters + tid * 64, __ATOMIC_RELAXED, __HIP_MEMORY_SCOPE_AGENT) < limit ? 1 : 0;
    __syncthreads();
    unsigned m = 0;
#pragma unroll
    for (int q = 0; q < 8; ++q) m |= fl[q] ? (1u << q) : 0u;
    __syncthreads();
    return m;
}
DI unsigned my_xcc() { return ((unsigned)__builtin_amdgcn_s_getreg((3 << 11) | 20) & 0xFu) & 7u; }

DI void phase_mix_even(const Params& p, unsigned char* shm, int cslot) {
    float lam;
    {
        const int lane = tidx() & 63;
        float a = p.e_lam[lane] * p.e_lam[64 + lane], b = p.e_lam[128 + lane] * p.e_lam[192 + lane];
#pragma unroll
        for (int o = 32; o >= 1; o >>= 1) { a += __shfl_xor(a, o); b += __shfl_xor(b, o); }
        lam = __expf(a) - __expf(b) + 0.2f;
    }
    unsigned* counters = (unsigned*)(p.ws + OFF_CNT) + cslot * 512;
    const unsigned x0 = my_xcc();
    unsigned left = 0xffu;
    for (unsigned k = 0; k < 8; ++k) {
        const int x = (int)((x0 + k) & 7u);
        if (k == 1) left = queues_left(shm, counters, 136u);
        if (!((left >> x) & 1u)) continue;
        for (;;) {
            const int it = pop_item(shm, counters + x * 64);
            if (it >= 136) break;
            if (it < 8) scan_item<16>(p, shm, false, x, it);
            else if (it < 72) { const int j = it - 8; diff_attn_item(p, shm, false, x, j >> 4, j & 15, lam); }
            else if (it < 104) { const int j = it - 72; scan_item<8>(p, shm, true, x * 4 + (j >> 3), j & 7); }
            else { const int j = it - 104; diff_attn_item(p, shm, true, x * 4 + (j >> 3), (j >> 1) & 3, j & 1, lam); }
        }
    }
}
DI void phase_mix_odd(const Params& p, unsigned char* shm, int cslot) {
    unsigned* counters = (unsigned*)(p.ws + OFF_CNT) + 1024 + cslot * 512;
    const unsigned x0 = my_xcc();
    unsigned left = 0xffu;
    for (unsigned k = 0; k < 8; ++k) {
        const int x = (int)((x0 + k) & 7u);
        if (k == 1) left = queues_left(shm, counters, 192u);
        if (!((left >> x) & 1u)) continue;
        for (;;) {
            const int it = pop_item(shm, counters + x * 64);
            if (it >= 192) break;
            if (it < 128) win_attn_item(p, shm, false, x, it >> 3, it & 7);
            else { const int j = it - 128; win_attn_item(p, shm, true, x * 4 + (j >> 4), j & 15, 0); }
        }
    }
}

#define XB_TMO      128
#define XB_XCNT(j)  (256  + 64 * (j))
#define XB_XSUB(j)  (1280 + 64 * (j))
#define XB_XGEN(j)  (2304 + 64 * (j))
#define XB_TOP      3328
#define XB_TOPGEN   3392
#define XCD_BAR_WORDS 3456
#define XB_SPIN_CAP (1u << 18)
#define LAS __attribute__((address_space(3)))
DI unsigned xb_ld(unsigned* p)              { return __hip_atomic_load(p, __ATOMIC_RELAXED, __HIP_MEMORY_SCOPE_AGENT); }
DI unsigned xb_add(unsigned* p, unsigned v) { return __hip_atomic_fetch_add(p, v, __ATOMIC_RELAXED, __HIP_MEMORY_SCOPE_AGENT); }
DI unsigned xb_xcc_id() { return (unsigned)__builtin_amdgcn_s_getreg((3 << 11) | 20) & 0xFu; }
#define XB_SPIN(cond, bar) do { unsigned _sp = 0; while (cond) { __builtin_amdgcn_s_sleep(1); \
    if ((++_sp & 255u) == 0u) { if (xb_ld(&(bar)[XB_TMO])) break; if (_sp > XB_SPIN_CAP) { atomicAdd(&(bar)[XB_TMO], 1u); break; } } } } while (0)
struct XcdBarrier { unsigned* bar; unsigned x; volatile LAS unsigned* st; };
DI XcdBarrier xcd_barrier_post(unsigned* bar, volatile LAS unsigned* st) {
    XcdBarrier b; b.bar = bar; b.x = xb_xcc_id(); b.st = st;
    if (threadIdx.x == 0) (void)xb_add(&bar[XB_XCNT(b.x)], 1u);
    return b;
}
DI void xcd_barrier_complete(unsigned* bar, unsigned x, unsigned& nloc, unsigned& nx) {
    const unsigned G = gridDim.x * gridDim.y * gridDim.z;
    unsigned sum, cnt, mine, sp = 0u;
    for (;;) {
        sum = 0u; cnt = 0u; mine = 0u;
#pragma unroll
        for (unsigned j = 0; j < 16; ++j) { const unsigned c = xb_ld(&bar[XB_XCNT(j)]); sum += c; cnt += (c > 0u) ? 1u : 0u; mine = (j == x) ? c : mine; }
        if (sum == G) break;
        __builtin_amdgcn_s_sleep(1);
        if ((++sp & 255u) == 0u) { if (xb_ld(&bar[XB_TMO])) break; if (sp > XB_SPIN_CAP) { atomicAdd(&bar[XB_TMO], 1u); break; } }
    }
    nloc = mine > 0u ? mine : 1u; nx = cnt > 0u ? cnt : 1u;
}
DI void xcd_barrier(const XcdBarrier& b) {
    asm volatile("s_waitcnt vmcnt(0)" ::: "memory");
    __syncthreads();
    if (threadIdx.x == 0) {
        unsigned* bar = b.bar;
        __builtin_amdgcn_s_waitcnt(0);
        unsigned nloc = b.st[0], nx = b.st[1];
        if (nloc == 0u) { xcd_barrier_complete(bar, b.x, nloc, nx); b.st[0] = nloc; b.st[1] = nx; }
        const unsigned old = xb_add(&bar[XB_XSUB(b.x)], 1u);
        const unsigned gen = old / nloc;
        if (old + 1u == (gen + 1u) * nloc) {
            __builtin_amdgcn_fence(__ATOMIC_RELEASE, "agent");
            asm volatile("s_waitcnt vmcnt(0)" ::: "memory");
            const unsigned og = xb_add(&bar[XB_TOP], 1u);
            const unsigned tg = og / nx;
            if (og + 1u == (tg + 1u) * nx) xb_add(&bar[XB_TOPGEN], 1u);
            else XB_SPIN(xb_ld(&bar[XB_TOPGEN]) == tg, bar);
            __builtin_amdgcn_fence(__ATOMIC_ACQUIRE, "agent");
            xb_add(&bar[XB_XGEN(b.x)], 1u);
            asm volatile("s_waitcnt vmcnt(0)" ::: "memory");
        } else {
            XB_SPIN(xb_ld(&bar[XB_XGEN(b.x)]) == gen, bar);
            __builtin_amdgcn_fence(__ATOMIC_ACQUIRE, "agent");
            asm volatile("s_waitcnt vmcnt(0)" ::: "memory");
        }
    }
    __syncthreads();
}

DI void run_phase(const Params& p, unsigned char* shm, int ph, int cslot) {
    unsigned char* ws = p.ws;
    const float* modbuf = (const float*)(ws + OFF_MOD);
    bf16_t* H = (bf16_t*)(ws + P_H);
#ifndef TESTQ
    if (ph == 0) { phase_prep(p, shm); return; }
#endif
    const int l = (ph - 1) < 12 ? 0 : 1;
    int q = ph - 1 - l * 12;
    if (l == 1 && q >= 6) q += 1;
#ifdef TESTQ
    if (q != TESTQ || l != TESTL) return;
#endif
    switch (q) {
        case 0: phase_norm(p, l, 0, l == 0); break;
        case 1: { EpiSwiglu E{(bf16_t*)(ws + P_U)}; run_gemm(shm, H, (const bf16_t*)(ws + OFF_W13 + (size_t)(l * 2 + 0) * SZ_W13), 5632, 1024, E); } break;
        case 2: { EpiResid3 E{l == 0 ? p.x_prompt : p.out, l == 0 ? p.x_sample : p.out + (size_t)MP * DM, p.out, modbuf + (size_t)l * 9 * 9216 + 2 * 1024, 0.5f, 0};
                  run_gemm_resid192(shm, (const bf16_t*)(ws + P_U), (const bf16_t*)(ws + OFF_W2 + (size_t)(l * 2 + 0) * SZ_W2), DFF, E); } break;
        case 3: phase_norm(p, l, 1, false); break;
        case 4: if (l == 0) { EpiSplit E{(bf16_t*)(ws + P_XR), (bf16_t*)(ws + P_GT), (bf16_t*)(ws + P_QKV), 512, 512, 1536, 2, 2}; run_gemm(shm, H, (const bf16_t*)(ws + OFF_EWIN), 2560, 1024, E); }
                else { EpiSplit E{(bf16_t*)(ws + P_QKV), (bf16_t*)(ws + P_QKV), (bf16_t*)(ws + P_QKV), 1536, 1536, 1536, 0, 0}; run_gemm(shm, H, (const bf16_t*)(ws + OFF_OWIN), 1536, 1024, E); } break;
        case 5: if (l == 0) phase_post_even(p, shm); else phase_post_odd(p, shm); break;
        case 6: { EpiGates E{(const bf16_t*)(ws + P_H), (_Float16*)(ws + P_LAU), (_Float16*)(ws + P_LAU + 48 * MiB), p.e_lru_ba, p.e_lru_bi, p.e_lru_lam};
                  pg8::StaticOrder S; S.init(MTOK, 2048, (int)gridDim.x, (int)blockIdx.x);
                  pg8::gemm_phase<EpiGates, pg8::StaticOrder>((PG8_LAS unsigned char*)shm, pg8::Gemm{(const bf16_t*)(ws + P_H), (const bf16_t*)(ws + OFF_WG), MTOK, 2048, 512, 2, 128}, S, E); } break;
        case 7: if (l == 0) phase_mix_even(p, shm, cslot); else phase_mix_odd(p, shm, cslot); break;
        case 8: { EpiResid3 E{p.out, p.out + (size_t)MP * DM, p.out, modbuf + (size_t)l * 9 * 9216 + 5 * 1024, 1.0f, 0};
                  run_gemm_resid192(shm, H, (const bf16_t*)(ws + (l == 0 ? OFF_EWOUT : OFF_OWOUT)), 1024, E); } break;
        case 9: phase_norm(p, l, 2, false); break;
        case 10: { EpiSwiglu E{(bf16_t*)(ws + P_U)}; run_gemm(shm, H, (const bf16_t*)(ws + OFF_W13 + (size_t)(l * 2 + 1) * SZ_W13), 5632, 1024, E); } break;
        case 11: { EpiResid3 E{p.out, p.out + (size_t)MP * DM, p.out, modbuf + (size_t)l * 9 * 9216 + 8 * 1024, 0.5f, 0};
                   run_gemm_resid192(shm, (const bf16_t*)(ws + P_U), (const bf16_t*)(ws + OFF_W2 + (size_t)(l * 2 + 1) * SZ_W2), DFF, E); } break;
        default: break;
    }
}

__global__ void __launch_bounds__(512) trunk_megakernel(Params p) {
    extern __shared__ __attribute__((aligned(16))) unsigned char shm[];
    cg::grid_group grid = cg::this_grid();
    volatile LAS unsigned* st = (volatile LAS unsigned*)(shm + LDS_BYTES);
    if (threadIdx.x == 0) { st[0] = 0u; st[1] = 0u; }
    __syncthreads();
    XcdBarrier xb = xcd_barrier_post((unsigned*)(p.ws + OFF_BAR), st);
    for (int ph = p.p0; ph < p.p1; ++ph) {
        run_phase(p, shm, ph, 0);
        if (PROBE_PH >= 0 && ph == PROBE_PH) { xcd_barrier(xb); run_phase(p, shm, ph, 1); }
        if (ph + 1 < p.p1) { if (ph == p.p0) grid.sync(); else xcd_barrier(xb); }
    }
}

extern "C" void kernel_launch(void* const* d_in, const int* in_sizes, int n_in, void* d_out, int out_size, void* d_ws, size_t ws_size, hipStream_t stream) {
    static int grid_blocks = 0;
    if (!grid_blocks) {
        int dev = 0, cus = 0, per_cu = 0;
        hipGetDevice(&dev);
        hipDeviceGetAttribute(&cus, hipDeviceAttributeMultiprocessorCount, dev);
        hipFuncSetAttribute((const void*)trunk_megakernel, hipFuncAttributeMaxDynamicSharedMemorySize, LDS_TOTAL);
        hipOccupancyMaxActiveBlocksPerMultiprocessor(&per_cu, trunk_megakernel, 512, LDS_TOTAL);
        if (per_cu < 1) per_cu = 1;
        grid_blocks = cus * per_cu;
    }
    if (ws_size < WS_NEED + MiB) {
 fprintf(stderr, "workspace too small: %zu < %zu\n", ws_size, (size_t)WS_NEED); return; }
    Params p{};
    const float** pp = (const float**)&p;
    for (int i = 0; i < 33; ++i) pp[i] = (const float*)d_in[i];
    p.out = (float*)d_out; p.ws = (unsigned char*)d_ws;
#if MULTI_LAUNCH
    for (int ph = 0; ph < NPHASE; ++ph) {
        p.p0 = ph; p.p1 = ph + 1;
        hipLaunchKernelGGL(trunk_megakernel, dim3(grid_blocks), dim3(512), LDS_TOTAL, stream, p);
    }
#else
    p.p0 = 0; p.p1 = NPHASE;
    hipMemsetAsync((unsigned char*)d_ws + OFF_CNT, 0, CNT_BYTES + XCD_BAR_WORDS * 4, stream);
    void* args[] = {&p};
    hipError_t e = hipLaunchCooperativeKernel((void*)trunk_megakernel, dim3(grid_blocks), dim3(512), args, LDS_TOTAL, stream);
    if (e != hipSuccess) fprintf(stderr, "cooperative launch failed: %s (grid %d)\n", hipGetErrorString(e), grid_blocks);
#endif
}
```

```cpp
#include <hip/hip_runtime.h>
#include <hip/hip_cooperative_groups.h>
#include <cstdio>
namespace cg = cooperative_groups;

#define DI __device__ __forceinline__
typedef unsigned short bf16_t;
typedef short bf16x8 __attribute__((ext_vector_type(8)));
typedef float f32x4 __attribute__((ext_vector_type(4)));
typedef float f32x16 __attribute__((ext_vector_type(16)));
typedef float f32x2 __attribute__((ext_vector_type(2)));
typedef __bf16 bf16x2n __attribute__((ext_vector_type(2)));
typedef unsigned u32x4 __attribute__((ext_vector_type(4)));
typedef unsigned u32x2 __attribute__((ext_vector_type(2)));
typedef _Float16 h16x4 __attribute__((ext_vector_type(4)));

#ifndef PROBE_PH
#define PROBE_PH -1
#endif
#ifndef MULTI_LAUNCH
#define MULTI_LAUNCH 0
#endif

constexpr int MTOK = 24576, MP = 8192, DM = 1024, DFF = 2816;
constexpr int NPHASE = 24;
constexpr int LDS_BYTES = 131072;
constexpr int LDS_TOTAL = LDS_BYTES + 64;
constexpr float LOG2E = 1.4426950408889634f;

constexpr size_t MiB = 1048576;
constexpr size_t OFF_W13 = 0;
constexpr size_t SZ_W13 = (size_t)5632 * 1024 * 2;
constexpr size_t OFF_W2 = OFF_W13 + 4 * SZ_W13;
constexpr size_t SZ_W2 = (size_t)1024 * 2816 * 2;
constexpr size_t OFF_EWIN = OFF_W2 + 4 * SZ_W2;
constexpr size_t OFF_EWOUT = OFF_EWIN + (size_t)2560 * 1024 * 2;
constexpr size_t OFF_OWIN = OFF_EWOUT + (size_t)1024 * 1024 * 2;
constexpr size_t OFF_OWOUT = OFF_OWIN + (size_t)1536 * 1024 * 2;
constexpr size_t OFF_WG = OFF_OWOUT + (size_t)1024 * 1024 * 2;
constexpr size_t OFF_KDC = OFF_WG + (size_t)2048 * 512 * 2;
constexpr size_t OFF_VDC = OFF_KDC + (size_t)64 * 512 * 64 * 2;
constexpr size_t OFF_KWC = OFF_VDC + (size_t)4096 * 512 * 2;
constexpr size_t OFF_VWC = OFF_KWC + (size_t)32 * 512 * 64 * 2;
constexpr size_t OFF_MOD = OFF_VWC + (size_t)2048 * 512 * 2;
constexpr size_t OFF_CNT = OFF_MOD + (size_t)2 * 9 * 9216 * 4;
constexpr size_t OFF_POOL = 93 * MiB;
constexpr size_t P_U = OFF_POOL;
constexpr size_t P_GT = OFF_POOL;
constexpr size_t P_XR = OFF_POOL + 24 * MiB;
constexpr size_t P_QKV = OFF_POOL + 48 * MiB;
constexpr size_t P_LAU = OFF_POOL + 24 * MiB;
constexpr size_t P_ATT = OFF_POOL + 120 * MiB;
constexpr size_t P_H = OFF_POOL + 192 * MiB;
constexpr size_t WS_NEED = OFF_POOL + 240 * MiB;
constexpr size_t OFF_BAR = OFF_CNT + 8192;
static_assert(OFF_BAR + 16384 <= OFF_POOL, "ws map");
constexpr size_t CNT_BYTES = 8192;

struct Params {
    const float *x_prompt, *x_sample, *cache_diff_k, *cache_diff_v, *state_lru, *cache_win_k, *cache_win_v, *c, *c_ctx, *norm_g, *w_mod, *b_mod,
        *ffn_w1, *ffn_w3, *ffn_w2, *e_w_in, *e_w_out, *e_conv_w, *e_conv_b, *e_lru_wa, *e_lru_ba, *e_lru_wi, *e_lru_bi, *e_lru_lam, *e_q_g, *e_k_g, *e_lam,
        *e_subln_g, *o_w_in, *o_w_out, *o_q_g, *o_k_g, *o_sink;
    float* out;
    unsigned char* ws;
    int p0, p1;
};

DI int tidx() { int t = threadIdx.x; asm volatile("" : "+v"(t)); return t; }
DI unsigned pack2(float lo, float hi) { f32x2 v = {lo, hi}; bf16x2n b = __builtin_convertvector(v, bf16x2n); return __builtin_bit_cast(unsigned, b); }
DI bf16_t f2bf(float f) { return (bf16_t)(pack2(f, 0.f) & 0xffffu); }
DI float bf2f(bf16_t b) { return __uint_as_float(((unsigned)b) << 16); }
DI float bflo(unsigned w) { return __uint_as_float(w << 16); }
DI float bfhi(unsigned w) { return __uint_as_float(w & 0xffff0000u); }
DI void unpack8(const u32x4 w, float (&v)[8]) { v[0] = bflo(w.x); v[1] = bfhi(w.x); v[2] = bflo(w.y); v[3] = bfhi(w.y); v[4] = bflo(w.z); v[5] = bfhi(w.z); v[6] = bflo(w.w); v[7] = bfhi(w.w); }
DI u32x4 pack8(const float (&v)[8]) { u32x4 w; w.x = pack2(v[0], v[1]); w.y = pack2(v[2], v[3]); w.z = pack2(v[4], v[5]); w.w = pack2(v[6], v[7]); return w; }
DI float sigmoid_f(float x) { return 1.f / (1.f + __expf(-x)); }
DI float fsigmoid(float x) { return __builtin_amdgcn_rcpf(1.f + __builtin_amdgcn_exp2f(-x * 1.4426950408889634f)); }
DI float silu_f(float x) { return x / (1.f + __expf(-x)); }
DI float silu_mul(float a, float b) { const float e = __builtin_amdgcn_exp2f(-a * 1.4426950408889634f); return a * b * __builtin_amdgcn_rcpf(1.f + e); }
DI float gelu_tanh(float x) { const float u = 0.7978845608028654f * (x + 0.044715f * x * x * x); return 0.5f * x * (1.f + tanhf(u)); }
DI float xhalf_max(float x) { const auto r = __builtin_amdgcn_permlane32_swap(__float_as_uint(x), __float_as_uint(x), false, false); return fmaxf(__uint_as_float(r[0]), __uint_as_float(r[1])); }
DI int mod_row(int row) { return row < MP ? 0 : 1 + ((row - MP) >> 11); }

namespace pg8 {
#define PG8_LAS __attribute__((address_space(3)))
constexpr int BM = 256, BK = 64, HALF = 128, HTB = HALF * BK * 2, STAGE_BYTES = 8 * HTB, NXCD = 8, WGM = 8;
__host__ __device__ __forceinline__ int lds_byte(int r, int c) { const int st = (r >> 4) * 2 + (c >> 5), rr = r & 15, cc = c & 31, ob = rr * 64 + cc * 2; return st * 1024 + (ob ^ (((ob >> 9) & 1) << 5)); }
__host__ __device__ __forceinline__ void stage_rc(int b, int& R, int& C) { const int st = b / 1024, sb = b % 1024, swz = sb ^ (((sb >> 9) & 1) << 5); R = (st >> 1) * 16 + swz / 64; C = (st & 1) * 32 + (swz % 64) / 2; }
__host__ __device__ __forceinline__ int perm32(int rho) { const int n = rho >> 4, i = rho & 15; return 8 * (i >> 2) + 4 * n + (i & 3); }
struct Unit { int pm, pn; };
struct Gemm { const bf16_t* A; const bf16_t* Bt; int M, N, K, nk, kdiag; };
struct StaticOrder {
    int nM, nN, nwg, G, c;
    __device__ void init(int M, int N, int G_, int c_, int bm = BM) { nM = M / bm; nN = N / BM; nwg = nM * nN; G = G_; c = c_; }
    __device__ bool next(int i, Unit& u) const {
        const long L = (long)i * G + c; if (L >= nwg) return false;
        int wgid = (int)L; { const int q = nwg / NXCD, r = nwg % NXCD, xcd = wgid % NXCD, off = wgid / NXCD; wgid = (xcd < r ? xcd * (q + 1) : r * (q + 1) + (xcd - r) * q) + off; }
        const int nig = WGM * nN, gid = wgid / nig, fm = gid * WGM, gsz = (nM - fm) < WGM ? (nM - fm) : WGM;
        u.pm = fm + ((wgid % nig) % gsz); u.pn = (wgid % nig) / gsz; return true;
    }
    __device__ __forceinline__ void a_ready(const Unit&) const {}
    __device__ __forceinline__ void done(const Unit&) const {}
};

template <class Epi, class Sched, int MREP = 4>
__device__ __forceinline__ void gemm_phase(PG8_LAS unsigned char* lds, const Gemm g, const Sched& S, const Epi& E) {
    const int tid = tidx(), wid = __builtin_amdgcn_readfirstlane(tid >> 6), lane = tid & 63, wr = wid >> 2, wc = wid & 3, fr = lane & 15, fq = lane >> 4;
    const int K = g.K, nt = g.nk ? g.nk : K / BK;
    unsigned voffA[2], voffB[2];
#pragma unroll
    for (int i = 0; i < 2; ++i) { int R, C; stage_rc(tid * 16 + i * 8192, R, C); const int Rb = Epi::PERM ? ((R & ~31) + perm32(R & 31)) : R;
        voffA[i] = (unsigned)(R * K + C) * 2u; voffB[i] = (unsigned)(Rb * K + C) * 2u; }
    const size_t kstep = (size_t)(BK * 2);
    const size_t hstep = (size_t)(32 * MREP) * K * 2;
    const size_t hstepB = (size_t)HALF * K * 2;
    const size_t tstep = 2 * hstep, tstepB = 2 * hstepB;
    const unsigned ldsw = (unsigned)wid * 1024u;
    const int aoff = lds_byte(wr * (16 * MREP) + fr, fq * 8), boff = lds_byte(wc * 32 + fr, fq * 8);
#define PG8_SA(b, h) (((b) * 2 + (h)) * HTB)
#define PG8_SB(b, h) ((4 + (b) * 2 + (h)) * HTB)
#define PG8_STAGE(bufoff, gbase, voff) do { _Pragma("unroll") for (int _i = 0; _i < 2; ++_i) \
        __builtin_amdgcn_global_load_lds((const unsigned*)((const char*)(gbase) + (voff)[_i]), (PG8_LAS unsigned*)(lds + (bufoff) + ldsw + _i * 8192), 16, 0, 0); } while (0)
#define PG8_LDA(dst, b, h) do { _Pragma("unroll") for (int m = 0; m < MREP; ++m) _Pragma("unroll") for (int k = 0; k < 2; ++k) dst[m][k] = *(const PG8_LAS bf16x8*)(lds + PG8_SA(b, h) + aoff + m * 2048 + k * 1024); } while (0)
#define PG8_LDB(dst, b, h) do { _Pragma("unroll") for (int n = 0; n < 2; ++n) _Pragma("unroll") for (int k = 0; k < 2; ++k) dst[n][k] = *(const PG8_LAS bf16x8*)(lds + PG8_SB(b, h) + boff + n * 2048 + k * 1024); } while (0)
#define PG8_MMA(ai, bj, At, Bt) do { __builtin_amdgcn_s_setprio(1); _Pragma("unroll") for (int m = 0; m < MREP; ++m) _Pragma("unroll") for (int n = 0; n < 2; ++n) _Pragma("unroll") for (int k = 0; k < 2; ++k) \
        acc[ai][bj][m][n] = __builtin_amdgcn_mfma_f32_16x16x32_bf16(Bt[n][k], At[m][k], acc[ai][bj][m][n], 0, 0, 0); __builtin_amdgcn_s_setprio(0); } while (0)
#define PG8_WAIT_V(n) asm volatile("s_waitcnt vmcnt(" #n ")" ::: "memory")
#define PG8_WAIT_L(n) asm volatile("s_waitcnt lgkmcnt(" #n ")" ::: "memory")
#define PG8_BAR __builtin_amdgcn_s_barrier()
#define PG8_SCHED __builtin_amdgcn_sched_barrier(0)
    Unit cur, nxt; int ui = 0;
    if (!S.next(0, cur)) return;
    f32x4 acc[2][2][MREP][2];
#pragma unroll
    for (int a = 0; a < 2; ++a)
#pragma unroll
        for (int b = 0; b < 2; ++b)
#pragma unroll
            for (int m = 0; m < MREP; ++m)
#pragma unroll
                for (int n = 0; n < 2; ++n) acc[a][b][m][n] = (f32x4){0.f, 0.f, 0.f, 0.f};
    bf16x8 At[MREP][2], B0[2][2], B1[2][2];
    const char* cA = (const char*)g.A + (size_t)cur.pm * tstep + (size_t)(g.kdiag * (cur.pn & 3)) * 2; const char* cB = (const char*)g.Bt + (size_t)cur.pn * tstepB + (size_t)(g.kdiag * (cur.pn & 3)) * 2;
    S.a_ready(cur);
    PG8_STAGE(PG8_SB(0, 0), cB, voffB); PG8_STAGE(PG8_SA(0, 0), cA, voffA); PG8_STAGE(PG8_SB(0, 1), cB + hstepB, voffB); PG8_STAGE(PG8_SA(0, 1), cA + hstep, voffA);
    if (wr == 1) PG8_BAR;
    PG8_WAIT_V(4); PG8_BAR;
    PG8_STAGE(PG8_SB(1, 0), cB + kstep, voffB); PG8_STAGE(PG8_SA(1, 0), cA + kstep, voffA); PG8_STAGE(PG8_SB(1, 1), cB + hstepB + kstep, voffB);
    PG8_WAIT_V(6); PG8_BAR;
    for (;;) {
        const bool has_next = S.next(ui + 1, nxt);
        const char* nA = has_next ? (const char*)g.A + (size_t)nxt.pm * tstep + (size_t)(g.kdiag * (nxt.pn & 3)) * 2 : cA; const char* nB = has_next ? (const char*)g.Bt + (size_t)nxt.pn * tstepB + (size_t)(g.kdiag * (nxt.pn & 3)) * 2 : cB;
        for (int t = 0; t < nt; t += 2) {
            const bool last = (t == nt - 2);
            const char* a1 = cA + (size_t)(t + 1) * kstep;
            const char* a2 = last ? nA : cA + (size_t)(t + 2) * kstep; const char* b2 = last ? nB : cB + (size_t)(t + 2) * kstep;
            const char* a3 = a2 + kstep; const char* b3 = b2 + kstep;
            if (last && has_next) S.a_ready(nxt);
            PG8_LDB(B0, 0, 0); PG8_SCHED; PG8_LDA(At, 0, 0); PG8_STAGE(PG8_SA(1, 1), a1 + hstep, voffA);
            if constexpr (MREP == 4) PG8_WAIT_L(8); else PG8_WAIT_L(6); PG8_BAR; PG8_WAIT_L(0); PG8_MMA(0, 0, At, B0); PG8_BAR; PG8_SCHED;
            PG8_LDB(B1, 0, 1); PG8_STAGE(PG8_SB(0, 0), b2, voffB);
            PG8_BAR; PG8_WAIT_L(0); PG8_MMA(0, 1, At, B1); PG8_BAR;
            PG8_LDA(At, 0, 1); PG8_STAGE(PG8_SA(0, 0), a2, voffA);
            PG8_BAR; PG8_WAIT_L(0); PG8_MMA(1, 0, At, B0); PG8_BAR; PG8_SCHED;
            PG8_STAGE(PG8_SB(0, 1), b2 + hstepB, voffB);
            PG8_WAIT_V(6); PG8_BAR; PG8_MMA(1, 1, At, B1); PG8_BAR;
            PG8_LDB(B0, 1, 0); PG8_SCHED; PG8_LDA(At, 1, 0); PG8_STAGE(PG8_SA(0, 1), a2 + hstep, voffA);
            if constexpr (MREP == 4) PG8_WAIT_L(8); else PG8_WAIT_L(6); PG8_BAR; PG8_WAIT_L(0); PG8_MMA(0, 0, At, B0); PG8_BAR; PG8_SCHED;
            PG8_LDB(B1, 1, 1); PG8_STAGE(PG8_SB(1, 0), b3, voffB);
            PG8_BAR; PG8_WAIT_L(0); PG8_MMA(0, 1, At, B1); PG8_BAR;
            PG8_LDA(At, 1, 1); PG8_STAGE(PG8_SA(1, 0), a3, voffA);
            PG8_BAR; PG8_WAIT_L(0); PG8_MMA(1, 0, At, B0); PG8_BAR; PG8_SCHED;
            PG8_STAGE(PG8_SB(1, 1), b3 + hstepB, voffB);
            PG8_WAIT_V(6); PG8_BAR; PG8_MMA(1, 1, At, B1); PG8_BAR;
        }
        E(acc, cur, wr, wc, fr, fq); S.done(cur);
        if (!has_next) break;
#pragma unroll
        for (int a = 0; a < 2; ++a)
#pragma unroll
            for (int b = 0; b < 2; ++b)
#pragma unroll
                for (int m = 0; m < MREP; ++m)
#pragma unroll
                    for (int n = 0; n < 2; ++n) acc[a][b][m][n] = (f32x4){0.f, 0.f, 0.f, 0.f};
        cur = nxt; cA = nA; cB = nB; ++ui;
    }
    PG8_WAIT_V(0);
    if (wr == 0) PG8_BAR;
    PG8_BAR;
#undef PG8_SA
#undef PG8_SB
#undef PG8_STAGE
#undef PG8_LDA
#undef PG8_LDB
#undef PG8_MMA
#undef PG8_WAIT_V
#undef PG8_WAIT_L
#undef PG8_BAR
#undef PG8_SCHED
}
}
using pg8::Unit;

struct EpiSwiglu {
    static constexpr bool PERM = true;
    bf16_t* U;
    DI void operator()(const f32x4 (&acc)[2][2][4][2], const Unit& u, int wr, int wc, int fr, int fq) const {
        asm volatile("" : "+v"(fr), "+v"(fq));
        const int row0 = u.pm * 256 + wr * 64 + fr, col0 = u.pn * 128 + wc * 32 + 8 * fq;
#pragma unroll
        for (int ai = 0; ai < 2; ++ai)
#pragma unroll
            for (int m = 0; m < 4; ++m) {
                bf16_t* rowp = U + (size_t)(row0 + ai * 128 + m * 16) * DFF + col0;
                float v[8];
#pragma unroll
                for (int n = 0; n < 2; ++n)
#pragma unroll
                    for (int j = 0; j < 4; ++j) v[n * 4 + j] = silu_mul(acc[ai][0][m][n][j], acc[ai][1][m][n][j]);
                *(u32x4*)rowp = pack8(v);
            }
    }
};
struct EpiResid {
    static constexpr bool PERM = false;
    const float* xp; const float* xs; float* out; const float* gate; float coef;
    DI void operator()(const f32x4 (&acc)[2][2][4][2], const Unit& u, int wr, int wc, int fr, int fq) const {
        asm volatile("" : "+v"(fr), "+v"(fq));
        const int rowt = u.pm * 256;
        const float* gp = gate + (size_t)mod_row(rowt) * 9216;
        const float* src = rowt < MP ? xp + (size_t)rowt * DM : xs + (size_t)(rowt - MP) * DM;
        float* dst = out + (size_t)rowt * DM;
        const int r0 = wr * 64 + fr, col0 = u.pn * 256 + wc * 32 + 4 * fq;
#pragma unroll
        for (int bj = 0; bj < 2; ++bj)
#pragma unroll
            for (int n = 0; n < 2; ++n) {
                const int cc = col0 + bj * 128 + n * 16;
                f32x4 xv[2][4];
#pragma unroll
                for (int ai = 0; ai < 2; ++ai)
#pragma unroll
                    for (int m = 0; m < 4; ++m) xv[ai][m] = *(const f32x4*)(src + (size_t)(r0 + ai * 128 + m * 16) * DM + cc);
                const f32x4 gv = *(const f32x4*)(gp + cc) * coef;
#pragma unroll
                for (int ai = 0; ai < 2; ++ai)
#pragma unroll
                    for (int m = 0; m < 4; ++m) *(f32x4*)(dst + (size_t)(r0 + ai * 128 + m * 16) * DM + cc) = xv[ai][m] + gv * acc[ai][bj][m][n];
            }
    }
};
struct EpiResid3 {
    static constexpr bool PERM = false;
    const float* xp; const float* xs; float* out; const float* gate; float coef; int pad_;
    DI void operator()(const f32x4 (&acc)[2][2][3][2], const Unit& u, int wr, int wc, int fr, int fq) const {
        asm volatile("" : "+v"(fr), "+v"(fq));
        const int rowt = u.pm * 192, rowb = rowt + wr * 48 + fr, col0 = u.pn * 256 + wc * 32 + 4 * fq;
        const int mr0 = mod_row(rowt);
        if (mr0 == mod_row(rowt + 191)) {
            const float* gp = gate + (size_t)mr0 * 9216;
            const float* src = rowt < MP ? xp : xs - (size_t)MP * DM;
#pragma unroll
            for (int bj = 0; bj < 2; ++bj)
#pragma unroll
                for (int n = 0; n < 2; ++n) {
                    const int cc = col0 + bj * 128 + n * 16;
                    f32x4 xv[2][3];
#pragma unroll
                    for (int ai = 0; ai < 2; ++ai)
#pragma unroll
                        for (int m = 0; m < 3; ++m) xv[ai][m] = *(const f32x4*)(src + (size_t)(rowb + ai * 96 + m * 16) * DM + cc);
                    const f32x4 gv = *(const f32x4*)(gp + cc) * coef;
#pragma unroll
                    for (int ai = 0; ai < 2; ++ai)
#pragma unroll
                        for (int m = 0; m < 3; ++m) *(f32x4*)(out + (size_t)(rowb + ai * 96 + m * 16) * DM + cc) = xv[ai][m] + gv * acc[ai][bj][m][n];
                }
        } else {
#pragma unroll
            for (int bj = 0; bj < 2; ++bj)
#pragma unroll
                for (int n = 0; n < 2; ++n) {
                    const int cc = col0 + bj * 128 + n * 16;
                    f32x4 xv[2][3], gv[2][3];
#pragma unroll
                    for (int ai = 0; ai < 2; ++ai)
#pragma unroll
                        for (int m = 0; m < 3; ++m) {
                            const int row = rowb + ai * 96 + m * 16;
                            const float* src = row < MP ? xp + (size_t)row * DM : xs + (size_t)(row - MP) * DM;
                            xv[ai][m] = *(const f32x4*)(src + cc);
                            gv[ai][m] = *(const f32x4*)(gate + (size_t)mod_row(row) * 9216 + cc);
                        }
#pragma unroll
                    for (int ai = 0; ai < 2; ++ai)
#pragma unroll
                        for (int m = 0; m < 3; ++m) {
                            const int row = rowb + ai * 96 + m * 16;
                            *(f32x4*)(out + (size_t)row * DM + cc) = xv[ai][m] + gv[ai][m] * coef * acc[ai][bj][m][n];
                        }
                }
        }
    }
};
struct EpiSplit {
    static constexpr bool PERM = true;
    bf16_t* b0; bf16_t* b1; bf16_t* b2; int ld0, ld1, ld2, n0, n1;
    DI void operator()(const f32x4 (&acc)[2][2][4][2], const Unit& u, int wr, int wc, int fr, int fq) const {
        asm volatile("" : "+v"(fr), "+v"(fq));
        bf16_t* base; int ld, ct;
        if (u.pn < n0) { base = b0; ld = ld0; ct = u.pn; } else if (u.pn < n0 + n1) { base = b1; ld = ld1; ct = u.pn - n0; } else { base = b2; ld = ld2; ct = u.pn - n0 - n1; }
        const int row0 = u.pm * 256 + wr * 64 + fr, col0 = ct * 256 + wc * 32 + 8 * fq;
#pragma unroll
        for (int ai = 0; ai < 2; ++ai)
#pragma unroll
            for (int m = 0; m < 4; ++m) {
                bf16_t* rowp = base + (size_t)(row0 + ai * 128 + m * 16) * ld + col0;
#pragma unroll
                for (int bj = 0; bj < 2; ++bj) {
                    u32x4 w; w.x = pack2(acc[ai][bj][m][0][0], acc[ai][bj][m][0][1]); w.y = pack2(acc[ai][bj][m][0][2], acc[ai][bj][m][0][3]);
                    w.z = pack2(acc[ai][bj][m][1][0], acc[ai][bj][m][1][1]); w.w = pack2(acc[ai][bj][m][1][2], acc[ai][bj][m][1][3]);
                    *(u32x4*)(rowp + bj * 128) = w;
                }
            }
    }
};
struct EpiGates {
    static constexpr bool PERM = false;
    const bf16_t* xc; _Float16* la; _Float16* uu; const float* ba; const float* bi; const float* lam;
    DI void operator()(const f32x4 (&acc)[2][2][4][2], const Unit& u, int wr, int wc, int fr, int fq) const {
        asm volatile("" : "+v"(fr), "+v"(fq));
        const int dir = u.pn >> 2, cgp = u.pn & 3;
        const int ch0 = cgp * 128 + wc * 32 + 4 * fq;
        _Float16* lad = la + (size_t)dir * MTOK * 512; _Float16* ud = uu + (size_t)dir * MTOK * 512;
#pragma unroll
        for (int n = 0; n < 2; ++n) {
            const int ch = ch0 + n * 16;
            float bav[4], biv[4], spv[4];
#pragma unroll
            for (int j = 0; j < 4; ++j) { const int cx = dir * 512 + ch + j; bav[j] = ba[cx]; biv[j] = bi[cx]; const float lm = lam[cx]; spv[j] = (lm < -15.f) ? -lm : log1pf(__expf(-lm)); }
            u32x2 xw[2][4];
#pragma unroll
            for (int ai = 0; ai < 2; ++ai)
#pragma unroll
                for (int m = 0; m < 4; ++m) xw[ai][m] = *(const u32x2*)(xc + (size_t)(u.pm * 256 + ai * 128 + wr * 64 + m * 16 + fr) * 512 + ch);
#pragma unroll
            for (int ai = 0; ai < 2; ++ai)
#pragma unroll
                for (int m = 0; m < 4; ++m) {
                    const size_t r = (size_t)(u.pm * 256 + ai * 128 + wr * 64 + m * 16 + fr);
                    const float xv[4] = {bflo(xw[ai][m].x), bfhi(xw[ai][m].x), bflo(xw[ai][m].y), bfhi(xw[ai][m].y)};
                    h16x4 lo, uo;
#pragma unroll
                    for (int j = 0; j < 4; ++j) {
                        const float rr = fsigmoid(acc[ai][0][m][n][j] + bav[j]), ii = fsigmoid(acc[ai][1][m][n][j] + biv[j]);
                        const float lg = -8.f * rr * spv[j];
                        lo[j] = (_Float16)lg; uo[j] = (_Float16)(ii * xv[j]);
                    }
                    *(h16x4*)(lad + r * 512 + ch) = lo; *(h16x4*)(ud + r * 512 + ch) = uo;
                }
        }
    }
};

template <class Epi>
DI void run_gemm(unsigned char* shm, const bf16_t* A, const bf16_t* Bt, int N, int K, const Epi& E) {
    pg8::StaticOrder S; S.init(MTOK, N, (int)gridDim.x, (int)blockIdx.x);
    pg8::gemm_phase<Epi, pg8::StaticOrder>((PG8_LAS unsigned char*)shm, pg8::Gemm{A, Bt, MTOK, N, K, 0, 0}, S, E);
}

DI void run_gemm_resid192(unsigned char* shm, const bf16_t* A, const bf16_t* Bt, int K, const EpiResid3& E) {
    pg8::StaticOrder S; S.init(MTOK, 1024, (int)gridDim.x, (int)blockIdx.x, 192);
    pg8::gemm_phase<EpiResid3, pg8::StaticOrder, 3>((PG8_LAS unsigned char*)shm, pg8::Gemm{A, Bt, MTOK, 1024, K, 0, 0}, S, E);
}

DI void transpose_tile(const float* __restrict__ src, int lds_, int k0, int n0, bf16_t* __restrict__ dst, int ldd, int drow0, int mode, float*) {
    const int tid = tidx(), lane = tid & 63, w = tid >> 6, kb = lane & 7, ng = lane >> 3;
    const int c = 32 * w + 4 * ng;
    const float* sp = src + (size_t)(k0 + 8 * kb) * lds_ + n0 + c;
    float4 v[8];
#pragma unroll
    for (int j = 0; j < 8; ++j) { const f32x4 t = __builtin_nontemporal_load((const f32x4*)(sp + (size_t)j * lds_)); v[j] = make_float4(t[0], t[1], t[2], t[3]); }
    const float x[4][8] = {{v[0].x, v[1].x, v[2].x, v[3].x, v[4].x, v[5].x, v[6].x, v[7].x}, {v[0].y, v[1].y, v[2].y, v[3].y, v[4].y, v[5].y, v[6].y, v[7].y},
                           {v[0].z, v[1].z, v[2].z, v[3].z, v[4].z, v[5].z, v[6].z, v[7].z}, {v[0].w, v[1].w, v[2].w, v[3].w, v[4].w, v[5].w, v[6].w, v[7].w}};
#pragma unroll
    for (int q = 0; q < 4; ++q) {
        const int cc = c + q;
        const int drow = mode ? drow0 + 256 * (cc >> 7) + (cc & 127) : drow0 + cc;
        *(u32x4*)(dst + (size_t)drow * ldd + k0 + 8 * kb) = pack8(x[q]);
    }
}

DI void phase_prep(const Params& p, unsigned char* shm) {
    const int tid = tidx();
    unsigned char* ws = p.ws;
    float* s_silu = (float*)shm;
    float* red = (float*)(shm + 36864);
    float* tile = (float*)(shm + 36864 + 18432);
    if (blockIdx.x == 0) for (int i = tid; i < (int)(CNT_BYTES / 4); i += 512) ((unsigned*)(ws + OFF_CNT))[i] = 0u;
    for (int i = tid; i < 9216; i += 512) { const int r = i >> 10, k = i & 1023; const float v = r == 0 ? p.c_ctx[k] : p.c[(r - 1) * 1024 + k]; s_silu[i] = silu_f(v); }
    __syncthreads();
    constexpr int N_MOD_IT = 576, N_TR = 2688, N_CK = 768, N_WG = 256;
    constexpr int TOTAL = N_MOD_IT + N_TR + N_CK + N_WG;
    float* modbuf = (float*)(ws + OFF_MOD);
    for (int item = blockIdx.x; item < TOTAL; item += gridDim.x) {
        if (item < N_MOD_IT) {
            const int l = item / 288, col0 = (item % 288) * 32, c = tid & 31, kg = tid >> 5;
            float acc[9];
#pragma unroll
            for (int r = 0; r < 9; ++r) acc[r] = 0.f;
            const float* wp = p.w_mod + (size_t)l * 1024 * 9216 + (size_t)(kg * 64) * 9216 + col0 + c;
            for (int k = 0; k < 64; k += 16) {
                float w[16];
#pragma unroll
                for (int q = 0; q < 16; ++q) w[q] = __builtin_nontemporal_load(wp + (size_t)(k + q) * 9216);
#pragma unroll
                for (int q = 0; q < 16; ++q)
#pragma unroll
                    for (int r = 0; r < 9; ++r) acc[r] += s_silu[r * 1024 + kg * 64 + k + q] * w[q];
            }
#pragma unroll
            for (int r = 0; r < 9; ++r) red[(kg * 9 + r) * 32 + c] = acc[r];
            __syncthreads();
            if (tid < 288) {
                const int r = tid >> 5, cc = tid & 31; float sacc = 0.f;
#pragma unroll
                for (int g = 0; g < 16; ++g) sacc += red[(g * 9 + r) * 32 + cc];
                modbuf[(size_t)(l * 9 + r) * 9216 + col0 + cc] = sacc + p.b_mod[l * 9216 + col0 + cc];
            }
            __syncthreads();
        } else if (item < N_MOD_IT + N_TR) {
            int t = item - N_MOD_IT;
            if (t < 2112) {
                const int ls = t / 528, r = t % 528, which = r / 176, tt = r % 176;
                if (which < 2) {
                    const float* src = (which == 0 ? p.ffn_w1 : p.ffn_w3) + (size_t)ls * 1024 * DFF;
                    const int kt = tt / 11, n0 = (tt % 11) * 256;
                    transpose_tile(src, DFF, kt * 64, n0, (bf16_t*)(ws + OFF_W13 + ls * SZ_W13), 1024, 2 * n0 + which * 128, 1, tile);
                } else {
                    const float* src = p.ffn_w2 + (size_t)ls * DFF * 1024;
                    const int kt = tt / 4, n0 = (tt % 4) * 256;
                    transpose_tile(src, 1024, kt * 64, n0, (bf16_t*)(ws + OFF_W2 + ls * SZ_W2), DFF, n0, 0, tile);
                }
            } else if ((t -= 2112) < 160) { transpose_tile(p.e_w_in, 2560, (t / 10) * 64, (t % 10) * 256, (bf16_t*)(ws + OFF_EWIN), 1024, (t % 10) * 256, 0, tile); }
            else if ((t -= 160) < 64) { transpose_tile(p.e_w_out, 1024, (t / 4) * 64, (t % 4) * 256, (bf16_t*)(ws + OFF_EWOUT), 1024, (t % 4) * 256, 0, tile); }
            else if ((t -= 64) < 96) { transpose_tile(p.o_w_in, 1536, (t / 6) * 64, (t % 6) * 256, (bf16_t*)(ws + OFF_OWIN), 1024, (t % 6) * 256, 0, tile); }
            else if ((t -= 96) < 64) { transpose_tile(p.o_w_out, 1024, (t / 4) * 64, (t % 4) * 256, (bf16_t*)(ws + OFF_OWOUT), 1024, (t % 4) * 256, 0, tile); }
            else if ((t -= 64) < 128) {
                const int b = t / 16, r = t % 16;
                transpose_tile(p.cache_diff_v + (size_t)b * 512 * 512, 512, (r / 2) * 64, (r % 2) * 256, (bf16_t*)(ws + OFF_VDC), 512, b * 512 + (r % 2) * 256, 0, tile);
            } else { t -= 128;
                const int b = t / 8, r = t % 8;
                transpose_tile(p.cache_win_v + (size_t)b * 512 * 256, 256, r * 64, 0, (bf16_t*)(ws + OFF_VWC), 512, b * 256, 0, tile);
            }
        } else if (item < N_MOD_IT + N_TR + N_CK) {
            const int j = item - N_MOD_IT - N_TR;
            if (j < 512) {
                const int ch = j * 512 + tid, d8 = ch & 7, m = (ch >> 3) & 1, h = (ch >> 4) & 3, t = (ch >> 6) & 511, b = ch >> 15;
                const float* s = p.cache_diff_k + (size_t)ch * 8; float v[8];
                const float4 a = *(const float4*)s, bq = *(const float4*)(s + 4); v[0] = a.x; v[1] = a.y; v[2] = a.z; v[3] = a.w; v[4] = bq.x; v[5] = bq.y; v[6] = bq.z; v[7] = bq.w;
                *(u32x4*)((bf16_t*)(ws + OFF_KDC) + ((size_t)(((b * 4 + h) * 2 + m) * 512 + t)) * 64 + d8 * 8) = pack8(v);
            } else {
                const int ch = (j - 512) * 512 + tid, d8 = ch & 7, kv = (ch >> 3) & 3, t = (ch >> 5) & 511, b = ch >> 14;
                const float* s = p.cache_win_k + (size_t)ch * 8; float v[8];
                const float4 a = *(const float4*)s, bq = *(const float4*)(s + 4); v[0] = a.x; v[1] = a.y; v[2] = a.z; v[3] = a.w; v[4] = bq.x; v[5] = bq.y; v[6] = bq.z; v[7] = bq.w;
                *(u32x4*)((bf16_t*)(ws + OFF_KWC) + ((size_t)((b * 4 + kv) * 512 + t)) * 64 + d8 * 8) = pack8(v);
            }
        } else {
            const int j = item - N_MOD_IT - N_TR - N_CK;
            const int ch_ = j * 512 + tid, nrow = ch_ >> 6, k8 = (ch_ & 63) * 8;
            const int pn = nrow >> 8, bj = (nrow >> 7) & 1, cp = nrow & 127, dir = pn >> 2, ch = (pn & 3) * 128 + cp, n = ch >> 6, jj = ch & 63;
            float v[8];
#pragma unroll
            for (int q = 0; q < 8; ++q) v[q] = 0.f;
            if ((k8 >> 6) == n) {
                const float* W = (bj ? p.e_lru_wi : p.e_lru_wa) + (size_t)((dir * 8 + n) * 64 + (k8 & 63)) * 64 + jj;
#pragma unroll
                for (int q = 0; q < 8; ++q) v[q] = W[q * 64];
            }
            *(u32x4*)((bf16_t*)(ws + OFF_WG) + (size_t)nrow * 512 + k8) = pack8(v);
        }
    }
}

DI void phase_norm(const Params& p, int l, int which, bool first) {
    const int tid = tidx(), lane = tid & 63, wid = tid >> 6;
    const float* g = p.norm_g + (l * 3 + which) * DM;
    const float* modbuf = (const float*)(p.ws + OFF_MOD);
    bf16_t* H = (bf16_t*)(p.ws + P_H);
    auto issue = [&](int g4, float4 (&v)[4][4]) __attribute__((always_inline)) {
        const int row = g4 * 4;
        const float* xr = first ? (row < MP ? p.x_prompt + (size_t)row * DM : p.x_sample + (size_t)(row - MP) * DM) : p.out + (size_t)row * DM;
#pragma unroll
        for (int rr = 0; rr < 4; ++rr)
#pragma unroll
            for (int i = 0; i < 4; ++i) v[rr][i] = *(const float4*)(xr + (size_t)rr * DM + i * 256 + lane * 4);
    };
    float4 v[4][4], vn[4][4];
    if ((int)blockIdx.x * 8 + wid < MTOK / 4) issue((int)blockIdx.x * 8 + wid, v);
    for (int g4 = blockIdx.x * 8 + wid; g4 < MTOK / 4; g4 += gridDim.x * 8) {
        const int row = g4 * 4;
        const float* sh = modbuf + (size_t)(l * 9 + mod_row(row)) * 9216 + which * 3 * 1024;
        const float* sc = sh + 1024;
        const bool more = g4 + (int)gridDim.x * 8 < MTOK / 4;
        if (more) issue(g4 + (int)gridDim.x * 8, vn);
        float ss[4];
#pragma unroll
        for (int rr = 0; rr < 4; ++rr) ss[rr] = 0.f;
#pragma unroll
        for (int rr = 0; rr < 4; ++rr)
#pragma unroll
            for (int i = 0; i < 4; ++i) ss[rr] += v[rr][i].x * v[rr][i].x + v[rr][i].y * v[rr][i].y + v[rr][i].z * v[rr][i].z + v[rr][i].w * v[rr][i].w;
#pragma unroll
        for (int o = 32; o >= 1; o >>= 1) {
#pragma unroll
            for (int rr = 0; rr < 4; ++rr) ss[rr] += __shfl_xor(ss[rr], o);
        }
        float rs[4];
#pragma unroll
        for (int rr = 0; rr < 4; ++rr) rs[rr] = rsqrtf(ss[rr] * (1.f / 1024.f) + 1e-6f);
#pragma unroll
        for (int i = 0; i < 4; ++i) {
            const int col = i * 256 + lane * 4;
            const float4 g4v = *(const float4*)(g + col), s4 = *(const float4*)(sc + col), h4 = *(const float4*)(sh + col);
            const float mx = g4v.x * (1.f + s4.x), my = g4v.y * (1.f + s4.y), mz = g4v.z * (1.f + s4.z), mw = g4v.w * (1.f + s4.w);
#pragma unroll
            for (int rr = 0; rr < 4; ++rr) {
                u32x2 w;
                w.x = pack2(v[rr][i].x * rs[rr] * mx + h4.x, v[rr][i].y * rs[rr] * my + h4.y);
                w.y = pack2(v[rr][i].z * rs[rr] * mz + h4.z, v[rr][i].w * rs[rr] * mw + h4.w);
                *(u32x2*)(H + (size_t)(row + rr) * DM + col) = w;
            }
        }
        if (more) {
#pragma unroll
            for (int rr = 0; rr < 4; ++rr)
#pragma unroll
                for (int i = 0; i < 4; ++i) v[rr][i] = vn[rr][i];
        }
    }
}

DI void qk_norm_rope(float (&v)[8], const float* g8, bool rope, const float (&cs)[8], const float (&sn)[8], int lane) {
    float ss = 0.f;
#pragma unroll
    for (int j = 0; j < 8; ++j) ss += v[j] * v[j];
    ss += __shfl_xor(ss, 1); ss += __shfl_xor(ss, 2); ss += __shfl_xor(ss, 4);
    const float rs = rsqrtf(ss * (1.f / 64.f) + 1e-6f);
#pragma unroll
    for (int j = 0; j < 8; ++j) v[j] = v[j] * rs * g8[j];
    float pv[8];
#pragma unroll
    for (int j = 0; j < 8; ++j) pv[j] = __shfl_xor(v[j], 2);
    if (rope) {
        const bool lowhalf = ((lane & 2) == 0);
#pragma unroll
        for (int j = 0; j < 8; ++j) v[j] = lowhalf ? (v[j] * cs[j] - pv[j] * sn[j]) : (v[j] * cs[j] + pv[j] * sn[j]);
    }
}
DI void rope_table_fill(float* T) {
    for (int idx = tidx(); idx < 1024; idx += 512) {
        const int pos = idx >> 4, fi = idx & 15;
        const float inv = exp2f(-(float)(2 * fi) * (13.287712379549449f / 32.f));
        float sv, cv; sincosf((float)pos * inv, &sv, &cv);
        T[idx * 2] = cv; T[idx * 2 + 1] = sv;
    }
    __syncthreads();
}
DI void rope_tables(const float* T, int s, int lane, float (&cs)[8], float (&sn)[8]) {
    const int d0 = (lane & 7) * 8;
    const int pos = (d0 < 32) ? (s >> 6) : (s & 63);
    const float4* tp = (const float4*)(T + ((pos << 4) + (d0 & 15)) * 2);
#pragma unroll
    for (int j = 0; j < 4; ++j) { const float4 v = tp[j]; cs[2 * j] = v.x; sn[2 * j] = v.y; cs[2 * j + 1] = v.z; sn[2 * j + 1] = v.w; }
}
DI void ld8(const bf16_t* p, float (&v)[8]) { unpack8(*(const u32x4*)p, v); }
DI void st8f(float* p, const float (&v)[8]) { *(float4*)p = make_float4(v[0], v[1], v[2], v[3]); *(float4*)(p + 4) = make_float4(v[4], v[5], v[6], v[7]); }

DI void phase_post_even(const Params& p, unsigned char* shm) {
    const int tid = tidx(), lane = tid & 63, wid = tid >> 6;
    unsigned char* ws = p.ws;
    const bf16_t* XR = (const bf16_t*)(ws + P_XR); const bf16_t* QKV = (const bf16_t*)(ws + P_QKV);
    bf16_t* Qd = (bf16_t*)(ws + P_ATT); bf16_t* Kd = (bf16_t*)(ws + P_ATT + 24 * MiB); bf16_t* Vtd = (bf16_t*)(ws + P_ATT + 48 * MiB);
    bf16_t* xc = (bf16_t*)(ws + P_H);
    float* o_dk = p.out + (size_t)MTOK * DM; float* o_dv = o_dk + (size_t)MP * 512;
    bf16_t* svt = (bf16_t*)shm;
    float* ropeT = (float*)(shm + 16384); rope_table_fill(ropeT);
    float gq[8], gk[8], cw[4][8], cb[8];
#pragma unroll
    for (int j = 0; j < 8; ++j) { gq[j] = p.e_q_g[(lane & 7) * 8 + j]; gk[j] = p.e_k_g[(lane & 7) * 8 + j]; cb[j] = p.e_conv_b[lane * 8 + j];
#pragma unroll
        for (int t = 0; t < 4; ++t) cw[t][j] = p.e_conv_w[t * 512 + lane * 8 + j]; }
    auto issue = [&](int it, u32x4& wq, u32x4& wk, u32x4& wv, u32x4 (&wx)[4]) __attribute__((always_inline)) {
        const int row = it * 8 + wid; const bool prm = row < MP; const int S = prm ? 256 : 2048, s = prm ? (row & 255) : ((row - MP) & 2047);
        const bf16_t* zr = QKV + (size_t)row * 1536;
        wq = *(const u32x4*)(zr + lane * 8); wk = *(const u32x4*)(zr + 512 + lane * 8); wv = *(const u32x4*)(zr + 1024 + lane * 8);
#pragma unroll
        for (int t = 0; t < 4; ++t) { const int sp = s + t - 2; const int rr = (sp >= 0 && sp < S) ? row + t - 2 : row; wx[t] = *(const u32x4*)(XR + (size_t)rr * 512 + lane * 8); }
    };
    u32x4 wq, wk, wv, wx[4];
    if ((int)blockIdx.x < MTOK / 8) issue((int)blockIdx.x, wq, wk, wv, wx);
    for (int it = blockIdx.x; it < MTOK / 8; it += gridDim.x) {
        const int row = it * 8 + wid;
        const bool prm = row < MP;
        const int S = prm ? 256 : 2048, tok0 = prm ? 0 : MP;
        const int b = prm ? (row >> 8) : ((row - MP) >> 11), s = prm ? (row & 255) : ((row - MP) & 2047);
        u32x4 nq = wq, nk = wk, nv = wv, nx[4] = {wx[0], wx[1], wx[2], wx[3]};
        if (it + (int)gridDim.x < MTOK / 8) issue(it + (int)gridDim.x, nq, nk, nv, nx);
        float cs[8], sn[8];
        if (!prm) rope_tables(ropeT, s, lane, cs, sn);
        else {
#pragma unroll
            for (int j = 0; j < 8; ++j) { cs[j] = 1.f; sn[j] = 0.f; }
        }
        float v[8];
        unpack8(wq, v); qk_norm_rope(v, gq, !prm, cs, sn, lane);
#pragma unroll
        for (int j = 0; j < 8; ++j) v[j] *= 0.125f * LOG2E;
        *(u32x4*)(Qd + ((size_t)tok0 * 8 + (size_t)(b * 8 + (lane >> 3)) * S + s) * 64 + (lane & 7) * 8) = pack8(v);
        unpack8(wk, v);
        if (prm) { float ss = 0.f;
#pragma unroll
            for (int j = 0; j < 8; ++j) ss += v[j] * v[j];
            ss += __shfl_xor(ss, 1); ss += __shfl_xor(ss, 2); ss += __shfl_xor(ss, 4);
            const float rs = rsqrtf(ss * (1.f / 64.f) + 1e-6f); float o[8];
#pragma unroll
            for (int j = 0; j < 8; ++j) o[j] = v[j] * rs * gk[j];
            st8f(o_dk + (size_t)row * 512 + lane * 8, o);
        }
        qk_norm_rope(v, gk, !prm, cs, sn, lane);
        *(u32x4*)(Kd + ((size_t)tok0 * 8 + (size_t)(b * 8 + (lane >> 3)) * S + s) * 64 + (lane & 7) * 8) = pack8(v);
        {
            const u32x4 w = wv;
            unpack8(w, v);
            if (prm) st8f(o_dv + (size_t)row * 512 + lane * 8, v);
            const bf16_t e[8] = {(bf16_t)(w.x & 0xffff), (bf16_t)(w.x >> 16), (bf16_t)(w.y & 0xffff), (bf16_t)(w.y >> 16), (bf16_t)(w.z & 0xffff), (bf16_t)(w.z >> 16), (bf16_t)(w.w & 0xffff), (bf16_t)(w.w >> 16)};
#pragma unroll
            for (int j = 0; j < 8; ++j) svt[(lane * 8 + j) * 8 + wid] = e[j];
        }
        {
            float a[8];
#pragma unroll
            for (int j = 0; j < 8; ++j) a[j] = cb[j];
#pragma unroll
            for (int t = 0; t < 4; ++t) {
                const int sp = s + t - 2;
                if (sp >= 0 && sp < S) { float x[8]; unpack8(wx[t], x);
#pragma unroll
                    for (int j = 0; j < 8; ++j) a[j] += x[j] * cw[t][j]; }
            }
            *(u32x4*)(xc + (size_t)row * 512 + lane * 8) = pack8(a);
        }
        __syncthreads();
        {
            const int row0 = it * 8, s0 = prm ? (row0 & 255) : ((row0 - MP) & 2047), b0 = prm ? (row0 >> 8) : ((row0 - MP) >> 11);
            const int S0 = prm ? 256 : 2048; const size_t t0 = prm ? 0 : (size_t)MP * 512;
            *(u32x4*)(Vtd + t0 + ((size_t)b0 * 512 + tid) * S0 + s0) = *(const u32x4*)(svt + tid * 8);
        }
        __syncthreads();
        wq = nq; wk = nk; wv = nv; wx[0] = nx[0]; wx[1] = nx[1]; wx[2] = nx[2]; wx[3] = nx[3];
    }
}

DI void phase_post_odd(const Params& p, unsigned char* shm) {
    const int tid = tidx(), lane = tid & 63, wid = tid >> 6;
    unsigned char* ws = p.ws;
    const bf16_t* QKV = (const bf16_t*)(ws + P_QKV);
    bf16_t* Qw = (bf16_t*)(ws + P_ATT); bf16_t* Kw = (bf16_t*)(ws + P_ATT + 48 * MiB); bf16_t* Vtw = (bf16_t*)(ws + P_ATT + 60 * MiB);
    float* o_wk = p.out + (size_t)MTOK * DM + (size_t)2 * MP * 512 + 32768; float* o_wv = o_wk + (size_t)MP * 256;
    bf16_t* svt = (bf16_t*)shm;
    float* ropeT = (float*)(shm + 16384); rope_table_fill(ropeT);
    float gq[8], gk[8];
#pragma unroll
    for (int j = 0; j < 8; ++j) { gq[j] = p.o_q_g[(lane & 7) * 8 + j]; gk[j] = p.o_k_g[(lane & 7) * 8 + j]; }
    u32x4 pw0 = {0u, 0u, 0u, 0u}, pw1 = pw0, pw2 = pw0;
    if ((int)blockIdx.x < MTOK / 8) { const bf16_t* zn = QKV + (size_t)((int)blockIdx.x * 8 + wid) * 1536; pw0 = *(const u32x4*)(zn + lane * 8); pw1 = *(const u32x4*)(zn + 512 + lane * 8); pw2 = *(const u32x4*)(zn + 1024 + lane * 8); }
    for (int it = blockIdx.x; it < MTOK / 8; it += gridDim.x) {
        const int row = it * 8 + wid;
        const bool prm = row < MP;
        const int S = prm ? 256 : 2048, tok0 = prm ? 0 : MP;
        const int b = prm ? (row >> 8) : ((row - MP) >> 11), s = prm ? (row & 255) : ((row - MP) & 2047);
        float cs[8], sn[8];
        if (!prm) rope_tables(ropeT, s, lane, cs, sn);
        else {
#pragma unroll
            for (int j = 0; j < 8; ++j) { cs[j] = 1.f; sn[j] = 0.f; }
        }
        const u32x4 wq2[2] = {pw0, pw1};
        const u32x4 wkv = pw2;
        if (it + (int)gridDim.x < MTOK / 8) { const bf16_t* zn = QKV + (size_t)((it + (int)gridDim.x) * 8 + wid) * 1536; pw0 = *(const u32x4*)(zn + lane * 8); pw1 = *(const u32x4*)(zn + 512 + lane * 8); pw2 = *(const u32x4*)(zn + 1024 + lane * 8); }
        float v[8];
#pragma unroll
        for (int ps = 0; ps < 2; ++ps) {
            unpack8(wq2[ps], v); qk_norm_rope(v, gq, !prm, cs, sn, lane);
#pragma unroll
            for (int j = 0; j < 8; ++j) v[j] *= 0.125f * LOG2E;
            const int head = ps * 8 + (lane >> 3);
            *(u32x4*)(Qw + ((size_t)tok0 * 16 + (size_t)(b * 16 + head) * S + s) * 64 + (lane & 7) * 8) = pack8(v);
        }
        const u32x4 w = wkv;
        unpack8(w, v);
        if (lane >= 32) {
            if (prm) st8f(o_wv + (size_t)row * 256 + (lane - 32) * 8, v);
            const bf16_t e[8] = {(bf16_t)(w.x & 0xffff), (bf16_t)(w.x >> 16), (bf16_t)(w.y & 0xffff), (bf16_t)(w.y >> 16), (bf16_t)(w.z & 0xffff), (bf16_t)(w.z >> 16), (bf16_t)(w.w & 0xffff), (bf16_t)(w.w >> 16)};
#pragma unroll
            for (int j = 0; j < 8; ++j) svt[((lane - 32) * 8 + j) * 8 + wid] = e[j];
        }
        {
            float ss = 0.f;
#pragma unroll
            for (int j = 0; j < 8; ++j) ss += v[j] * v[j];
            ss += __shfl_xor(ss, 1); ss += __shfl_xor(ss, 2); ss += __shfl_xor(ss, 4);
            const float rs = rsqrtf(ss * (1.f / 64.f) + 1e-6f);
            if (prm && lane < 32) { float o[8];
#pragma unroll
                for (int j = 0; j < 8; ++j) o[j] = v[j] * rs * gk[j];
                st8f(o_wk + (size_t)row * 256 + lane * 8, o); }
        }
        qk_norm_rope(v, gk, !prm, cs, sn, lane);
        if (lane < 32) *(u32x4*)(Kw + ((size_t)tok0 * 4 + (size_t)(b * 4 + (lane >> 3)) * S + s) * 64 + (lane & 7) * 8) = pack8(v);
        __syncthreads();
        if (tid < 256) {
            const int row0 = it * 8, s0 = prm ? (row0 & 255) : ((row0 - MP) & 2047), b0 = prm ? (row0 >> 8) : ((row0 - MP) >> 11);
            const int S0 = prm ? 256 : 2048; const size_t t0 = prm ? 0 : (size_t)MP * 256;
            *(u32x4*)(Vtw + t0 + ((size_t)b0 * 256 + tid) * S0 + s0) = *(const u32x4*)(svt + tid * 8);
        }
        __syncthreads();
    }
}

template <int BATCH>
DI void scan_item(const Params& p, unsigned char* shm, bool prm, int b, int cgi) {
    const int tid = tidx(), l16 = tid & 15, chunk = tid >> 4;
    unsigned char* ws = p.ws;
    const int S = prm ? 256 : 2048, tok0 = prm ? b * 256 : MP + b * 2048, Lc = S >> 5;
    const int ch = cgi * 64 + l16 * 4;
    const bf16_t* GT = (const bf16_t*)(ws + P_GT);
    bf16_t* Aout = (bf16_t*)(ws + P_H);
    float* sA = (float*)shm; float* sB = sA + 2048;
    float* o_st = p.out + (size_t)MTOK * DM + (size_t)2 * MP * 512;
#pragma unroll
    for (int dir = 0; dir < 2; ++dir) {
        const _Float16* LA = (const _Float16*)(ws + P_LAU) + (size_t)dir * MTOK * 512;
        const _Float16* UU = (const _Float16*)(ws + P_LAU + 48 * MiB) + (size_t)dir * MTOK * 512;
        float A[4] = {1.f, 1.f, 1.f, 1.f}, B[4] = {0.f, 0.f, 0.f, 0.f};
        for (int i0 = 0; i0 < Lc; i0 += BATCH) {
            h16x4 av[BATCH], uv[BATCH];
#pragma unroll
            for (int q = 0; q < BATCH; ++q) { const int pos = dir == 0 ? chunk * Lc + i0 + q : S - 1 - (chunk * Lc + i0 + q); const size_t idx = (size_t)(tok0 + pos) * 512 + ch; av[q] = *(const h16x4*)(LA + idx); uv[q] = *(const h16x4*)(UU + idx); }
#pragma unroll
            for (int q = 0; q < BATCH; ++q)
#pragma unroll
                for (int j = 0; j < 4; ++j) { const float e = __builtin_amdgcn_exp2f((float)av[q][j] * LOG2E); B[j] = e * B[j] + __builtin_amdgcn_sqrtf(fmaxf(1.f - e * e, 0.f)) * (float)uv[q][j]; A[j] *= e; }
        }
        *(float4*)(sA + chunk * 64 + l16 * 4) = make_float4(A[0], A[1], A[2], A[3]);
        *(float4*)(sB + chunk * 64 + l16 * 4) = make_float4(B[0], B[1], B[2], B[3]);
        __syncthreads();
        float hh[4];
#pragma unroll
        for (int j = 0; j < 4; ++j) hh[j] = prm ? 0.f : p.state_lru[(size_t)(b * 2 + dir) * 512 + ch + j];
        for (int cc = 0; cc < chunk; ++cc) {
            const float4 a4 = *(const float4*)(sA + cc * 64 + l16 * 4), b4 = *(const float4*)(sB + cc * 64 + l16 * 4);
            hh[0] = a4.x * hh[0] + b4.x; hh[1] = a4.y * hh[1] + b4.y; hh[2] = a4.z * hh[2] + b4.z; hh[3] = a4.w * hh[3] + b4.w;
        }
        for (int i0 = 0; i0 < Lc; i0 += BATCH) {
            h16x4 av[BATCH], uv[BATCH]; u32x2 gv[BATCH], hv[BATCH];
#pragma unroll
            for (int q = 0; q < BATCH; ++q) { const int pos = dir == 0 ? chunk * Lc + i0 + q : S - 1 - (chunk * Lc + i0 + q); const size_t t = (size_t)(tok0 + pos); av[q] = *(const h16x4*)(LA + t * 512 + ch); uv[q] = *(const h16x4*)(UU + t * 512 + ch);
                if (dir == 1) { gv[q] = *(const u32x2*)(GT + t * 512 + ch); hv[q] = *(const u32x2*)(Aout + t * 1024 + ch); } }
#pragma unroll
            for (int q = 0; q < BATCH; ++q) {
                const int pos = dir == 0 ? chunk * Lc + i0 + q : S - 1 - (chunk * Lc + i0 + q); const size_t t = (size_t)(tok0 + pos);
                float o[4];
#pragma unroll
                for (int j = 0; j < 4; ++j) { const float e = __builtin_amdgcn_exp2f((float)av[q][j] * LOG2E); hh[j] = e * hh[j] + __builtin_amdgcn_sqrtf(fmaxf(1.f - e * e, 0.f)) * (float)uv[q][j]; o[j] = hh[j]; }
                if (dir == 1) {
                    const float g[4] = {bflo(gv[q].x), bfhi(gv[q].x), bflo(gv[q].y), bfhi(gv[q].y)}, hf[4] = {bflo(hv[q].x), bfhi(hv[q].x), bflo(hv[q].y), bfhi(hv[q].y)};
#pragma unroll
                    for (int j = 0; j < 4; ++j) { const float x = g[j]; const float u2 = 1.5957691216057308f * (x + 0.044715f * x * x * x); o[j] = (hf[j] + hh[j]) * x * fsigmoid(u2); }
                }
                u32x2 w; w.x = pack2(o[0], o[1]); w.y = pack2(o[2], o[3]);
                *(u32x2*)(Aout + t * 1024 + ch) = w;
            }
        }
        if (prm && chunk == 31) {
#pragma unroll
            for (int j = 0; j < 4; ++j) o_st[(size_t)(b * 2 + dir) * 512 + ch + j] = hh[j];
        }
        __syncthreads();
    }
}

struct AttnSeg { const bf16_t* K0; const bf16_t* K1; const bf16_t* Vt; int ldv, kt0, nt; };
#define MFMA32(a, b, c) __builtin_amdgcn_mfma_f32_32x32x16_bf16((a), (b), (c), 0, 0, 0)

template <int NKB, int DV>
DI void attn_load(const AttnSeg& sg, int kt, u32x4 (&kr)[NKB], u32x4 (&vr)[DV / 64]) {
    const int tid = tidx(), key = tid >> 3, part = tid & 7;
    kr[0] = *(const u32x4*)(sg.K0 + (size_t)(kt * 64 + key) * 64 + part * 8);
    if (NKB == 2) kr[NKB - 1] = *(const u32x4*)(sg.K1 + (size_t)(kt * 64 + key) * 64 + part * 8);
#pragma unroll
    for (int i = 0; i < DV / 64; ++i) { const int c = tid + i * 512, e = c >> 3, pt = c & 7; vr[i] = *(const u32x4*)(sg.Vt + (size_t)e * sg.ldv + kt * 64 + pt * 8); }
}
template <int NKB, int DV>
DI void attn_store(unsigned char* buf, const u32x4 (&kr)[NKB], const u32x4 (&vr)[DV / 64]) {
    const int tid = tidx(), key = tid >> 3, part = tid & 7;
#pragma unroll
    for (int nb = 0; nb < NKB; ++nb) *(u32x4*)(buf + nb * (64 * 144) + key * 144 + part * 16) = kr[nb];
#pragma unroll
    for (int i = 0; i < DV / 64; ++i) { const int c = tid + i * 512, e = c >> 3, pt = c & 7; *(u32x4*)(buf + NKB * (64 * 144) + e * 144 + pt * 16) = vr[i]; }
}

template <int NKB, int DV, bool WIN>
DI void attn_run(unsigned char* shm, const AttnSeg& s0, const AttnSeg& s1, const bf16_t* Qmat, int qrow0, int kb, bool mask1, float m_init, float l_init,
                 f32x16 (&O)[DV / 32], float& l_out) {
    constexpr int BUF = (NKB * 64 + DV) * 144;
    const int lane = tidx() & 63, r = lane & 31, h = lane >> 5;
    const int pr = (r & ~12) | ((r & 4) << 1) | ((r & 8) >> 1);
    bf16x8 qf[4];
#pragma unroll
    for (int s = 0; s < 4; ++s) qf[s] = *(const bf16x8*)(Qmat + (size_t)(qrow0 + r) * 64 + 16 * s + 8 * h);
#pragma unroll
    for (int et = 0; et < DV / 32; ++et)
#pragma unroll
        for (int i = 0; i < 16; ++i) O[et][i] = 0.f;
    float m = m_init, l = l_init;
    const int ntot = s0.nt + s1.nt;
    u32x4 krA[NKB], vrA[DV / 64], krB[NKB], vrB[DV / 64];
    auto load_tile = [&](int t, u32x4 (&kr)[NKB], u32x4 (&vr)[DV / 64]) __attribute__((always_inline)) {
        if (t < ntot) { if (t < s0.nt) attn_load<NKB, DV>(s0, s0.kt0 + t, kr, vr); else attn_load<NKB, DV>(s1, s1.kt0 + (t - s0.nt), kr, vr); }
    };
    auto compute_tile = [&](int t, const unsigned char* buf) __attribute__((always_inline)) {
        const bool inseg1 = t >= s0.nt;
        const int kpos0 = inseg1 ? (s1.kt0 + t - s0.nt) * 64 : 0;
        const bool masked = WIN && mask1 && inseg1;
        bool skip = false;
        if (masked) skip = (kpos0 > qrow0 + 31 + 128) || (kpos0 + 63 < qrow0 - 128);
        if (!skip) {
            const unsigned char* kbuf = buf + kb * (64 * 144);
            f32x16 st0, st1;
#pragma unroll
            for (int i = 0; i < 16; ++i) { st0[i] = 0.f; st1[i] = 0.f; }
            const unsigned char* vbuf = buf + NKB * (64 * 144);
            bf16x8 kf[8], vf[2][4];
#pragma unroll
            for (int s = 0; s < 4; ++s) {
                kf[2 * s] = *(const bf16x8*)(kbuf + pr * 144 + (16 * s + 8 * h) * 2);
                kf[2 * s + 1] = *(const bf16x8*)(kbuf + (32 + pr) * 144 + (16 * s + 8 * h) * 2);
            }
            __builtin_amdgcn_sched_barrier(0);
            __builtin_amdgcn_s_setprio(1);
#pragma unroll
            for (int s = 0; s < 4; ++s) { st0 = MFMA32(kf[2 * s], qf[s], st0); st1 = MFMA32(kf[2 * s + 1], qf[s], st1); }
            __builtin_amdgcn_s_setprio(0);
#pragma unroll
            for (int f = 0; f < 4; ++f)
                vf[0][f] = *(const bf16x8*)(vbuf + (32 * (f >> 2) + r) * 144 + (32 * ((f >> 1) & 1) + 16 * (f & 1) + 8 * h) * 2);
            __builtin_amdgcn_sched_barrier(0);
            if (masked) {
                const int qp = qrow0 + r;
#pragma unroll
                for (int i = 0; i < 16; ++i) {
                    const int kp = kpos0 + (i & 7) + 8 * h + 16 * (i >> 3);
                    int d0 = qp - kp; d0 = d0 < 0 ? -d0 : d0; int d1 = qp - (kp + 32); d1 = d1 < 0 ? -d1 : d1;
                    if (d0 > 128) st0[i] = -1e30f;
                    if (d1 > 128) st1[i] = -1e30f;
                }
            }
            float mx = fmaxf(st0[0], st1[0]);
#pragma unroll
            for (int i = 1; i < 16; ++i) mx = fmaxf(mx, fmaxf(st0[i], st1[i]));
            mx = xhalf_max(mx);
            const float mn = fmaxf(m, mx);
            if (__any(mn > m + 8.f)) {
                const float alpha = __builtin_amdgcn_exp2f(m - mn);
                l *= alpha;
#pragma unroll
                for (int et = 0; et < DV / 32; ++et)
#pragma unroll
                    for (int i = 0; i < 16; ++i) O[et][i] *= alpha;
                m = mn;
            }
            float ps = 0.f;
#pragma unroll
            for (int i = 0; i < 16; ++i) { st0[i] = __builtin_amdgcn_exp2f(st0[i] - m); st1[i] = __builtin_amdgcn_exp2f(st1[i] - m); ps += st0[i] + st1[i]; }
            l += ps;
            bf16x8 pf[2][2];
#pragma unroll
            for (int s2 = 0; s2 < 2; ++s2) {
                u32x4 w0, w1;
                w0.x = pack2(st0[8 * s2 + 0], st0[8 * s2 + 1]); w0.y = pack2(st0[8 * s2 + 2], st0[8 * s2 + 3]); w0.z = pack2(st0[8 * s2 + 4], st0[8 * s2 + 5]); w0.w = pack2(st0[8 * s2 + 6], st0[8 * s2 + 7]);
                w1.x = pack2(st1[8 * s2 + 0], st1[8 * s2 + 1]); w1.y = pack2(st1[8 * s2 + 2], st1[8 * s2 + 3]); w1.z = pack2(st1[8 * s2 + 4], st1[8 * s2 + 5]); w1.w = pack2(st1[8 * s2 + 6], st1[8 * s2 + 7]);
                pf[0][s2] = __builtin_bit_cast(bf16x8, w0); pf[1][s2] = __builtin_bit_cast(bf16x8, w1);
            }
#pragma unroll
            for (int b = 0; b < DV / 32; ++b) {
                if (b + 1 < DV / 32) {
#pragma unroll
                    for (int f = 0; f < 4; ++f)
                        vf[(b + 1) & 1][f] = *(const bf16x8*)(vbuf + (32 * (b + 1) + r) * 144 + (32 * ((f >> 1) & 1) + 16 * (f & 1) + 8 * h) * 2);
                }
                __builtin_amdgcn_sched_barrier(0);
                __builtin_amdgcn_s_setprio(1);
#pragma unroll
                for (int f = 0; f < 4; ++f) O[b] = MFMA32(vf[b & 1][f], pf[(f >> 1) & 1][f & 1], O[b]);
                __builtin_amdgcn_s_setprio(0);
                __builtin_amdgcn_sched_barrier(0);
            }
        }
    };
    load_tile(0, krA, vrA); load_tile(1, krB, vrB);
    attn_store<NKB, DV>(shm, krA, vrA);
    __syncthreads();
    load_tile(2, krA, vrA);
    for (int t = 0; t < ntot; t += 2) {
        compute_tile(t, shm);
        attn_store<NKB, DV>(shm + BUF, krB, vrB);
        __syncthreads();
        load_tile(t + 3, krB, vrB);
        compute_tile(t + 1, shm + BUF);
        if (t + 2 < ntot) attn_store<NKB, DV>(shm, krA, vrA);
        __syncthreads();
        load_tile(t + 4, krA, vrA);
    }
    l_out = l + __shfl_xor(l, 32);
}

DI void diff_attn_item(const Params& p, unsigned char* shm, bool prm, int b, int hd, int qblk, float lam) {
    unsigned char* ws = p.ws;
    const int tid = tidx(), lane = tid & 63, wid = tid >> 6, r = lane & 31, h = lane >> 5;
    const int pair = wid >> 1, kb = wid & 1;
    const int S = prm ? 256 : 2048; const size_t tok0 = prm ? 0 : MP;
    const bf16_t* Qd = (const bf16_t*)(ws + P_ATT); const bf16_t* Kd = (const bf16_t*)(ws + P_ATT + 24 * MiB); const bf16_t* Vtd = (const bf16_t*)(ws + P_ATT + 48 * MiB);
    bf16_t* Aout = (bf16_t*)(ws + P_H);
    AttnSeg s0, s1;
    s0.K0 = (const bf16_t*)(ws + OFF_KDC) + (size_t)((b * 4 + hd) * 2) * 512 * 64; s0.K1 = s0.K0 + 512 * 64;
    s0.Vt = (const bf16_t*)(ws + OFF_VDC) + (size_t)(b * 512 + hd * 128) * 512; s0.ldv = 512; s0.kt0 = 0; s0.nt = prm ? 0 : 8;
    s1.K0 = Kd + (tok0 * 8 + (size_t)((b * 4 + hd) * 2) * S) * 64; s1.K1 = s1.K0 + (size_t)S * 64;
    s1.Vt = Vtd + tok0 * 512 + (size_t)(b * 512 + hd * 128) * S; s1.ldv = S; s1.kt0 = 0; s1.nt = S / 64;
    const bf16_t* Qmat = Qd + (tok0 * 8 + (size_t)((b * 4 + hd) * 2 + kb) * S) * 64;
    const int qrow0 = qblk * 128 + pair * 32;
    f32x16 O[4]; float lt;
    attn_run<2, 128, false>(shm, s0, s1, Qmat, qrow0, kb, false, -1e30f, 0.f, O, lt);
    const float inv = 1.f / lt;
    float* X = (float*)shm + pair * 4096;
    if (kb == 1) {
#pragma unroll
        for (int et = 0; et < 4; ++et)
#pragma unroll
            for (int i = 0; i < 16; ++i) X[(et * 16 + i) * 64 + lane] = O[et][i] * inv;
    }
    __syncthreads();
    if (kb == 0) {
        float ss = 0.f;
#pragma unroll
        for (int et = 0; et < 4; ++et)
#pragma unroll
            for (int i = 0; i < 16; ++i) { const float o = O[et][i] * inv - lam * X[(et * 16 + i) * 64 + lane]; O[et][i] = o; ss += o * o; }
        ss += __shfl_xor(ss, 32);
        const float rs = rsqrtf(ss * (1.f / 128.f) + 1e-6f) * 0.8f;
        const size_t row = (size_t)(prm ? b * 256 : MP + b * 2048) + qrow0 + r;
        bf16_t* op = Aout + row * 1024 + 512 + hd * 128;
#pragma unroll
        for (int et = 0; et < 4; ++et)
#pragma unroll
            for (int g = 0; g < 4; ++g) {
                const int e = 32 * et + 8 * g + 4 * h;
                const float4 sg = *(const float4*)(p.e_subln_g + e);
                u32x2 w; w.x = pack2(O[et][4 * g + 0] * rs * sg.x, O[et][4 * g + 1] * rs * sg.y); w.y = pack2(O[et][4 * g + 2] * rs * sg.z, O[et][4 * g + 3] * rs * sg.w);
                *(u32x2*)(op + e) = w;
            }
    }
    __syncthreads();
}

DI void win_attn_item(const Params& p, unsigned char* shm, bool prm, int b, int head, int qblk) {
    unsigned char* ws = p.ws;
    const int tid = tidx(), lane = tid & 63, wid = tid >> 6, r = lane & 31, h = lane >> 5;
    const int S = prm ? 256 : 2048; const size_t tok0 = prm ? 0 : MP; const int kv = head >> 2;
    const bf16_t* Qw = (const bf16_t*)(ws + P_ATT); const bf16_t* Kw = (const bf16_t*)(ws + P_ATT + 48 * MiB); const bf16_t* Vtw = (const bf16_t*)(ws + P_ATT + 60 * MiB);
    bf16_t* Aout = (bf16_t*)(ws + P_H);
    const int q0 = qblk * 256;
    AttnSeg s0, s1;
    s0.K0 = (const bf16_t*)(ws + OFF_KWC) + (size_t)(b * 4 + kv) * 512 * 64; s0.K1 = s0.K0;
    s0.Vt = (const bf16_t*)(ws + OFF_VWC) + (size_t)(b * 256 + kv * 64) * 512; s0.ldv = 512; s0.kt0 = 0; s0.nt = prm ? 0 : 8;
    s1.K0 = Kw + (tok0 * 4 + (size_t)(b * 4 + kv) * S) * 64; s1.K1 = s1.K0;
    s1.Vt = Vtw + tok0 * 256 + (size_t)(b * 256 + kv * 64) * S; s1.ldv = S;
    if (prm) { s1.kt0 = 0; s1.nt = 4; }
    else { const int lo = (q0 - 128 < 0 ? 0 : q0 - 128) >> 6, hi = (q0 + 384 > S ? S : q0 + 384) >> 6; s1.kt0 = lo; s1.nt = hi - lo; }
    const bf16_t* Qmat = Qw + (tok0 * 16 + (size_t)(b * 16 + head) * S) * 64;
    const int qrow0 = q0 + wid * 32;
    f32x16 O[2]; float lt;
    attn_run<1, 64, true>(shm, s0, s1, Qmat, qrow0, 0, !prm, p.o_sink[head] * LOG2E, h == 0 ? 1.f : 0.f, O, lt);
    const float inv = 1.f / lt;
    const size_t row = (size_t)(prm ? b * 256 : MP + b * 2048) + qrow0 + r;
    bf16_t* op = Aout + row * 1024 + head * 64;
#pragma unroll
    for (int et = 0; et < 2; ++et)
#pragma unroll
        for (int g = 0; g < 4; ++g) {
            const int e = 32 * et + 8 * g + 4 * h;
            u32x2 w; w.x = pack2(O[et][4 * g + 0] * inv, O[et][4 * g + 1] * inv); w.y = pack2(O[et][4 * g + 2] * inv, O[et][4 * g + 3] * inv);
            *(u32x2*)(op + e) = w;
        }
}

DI int pop_item(unsigned char* shm, unsigned* counter) {
    int* slot = (int*)(shm + LDS_BYTES + 16);
    if (tidx() == 0) *slot = (int)atomicAdd(counter, 1u);
    __syncthreads();
    const int it = *slot;
    __syncthreads();
    return it;
}
DI unsigned queues_left(unsigned char* shm, unsigned* counters, unsigned limit) {
    int* fl = (int*)(shm + LDS_BYTES + 32);
    const int tid = tidx();
    if (tid < 8) fl[tid] = __hip_atomic_load(counters + tid * 64, __ATOMIC_RELAXED, __HIP_MEMORY_SCOPE_AGENT) < limit ? 1 : 0;
    __syncthreads();
    unsigned m = 0;
#pragma unroll
    for (int q = 0; q < 8; ++q) m |= fl[q] ? (1u << q) : 0u;
    __syncthreads();
    return m;
}
DI unsigned my_xcc() { return ((unsigned)__builtin_amdgcn_s_getreg((3 << 11) | 20) & 0xFu) & 7u; }

DI void phase_mix_even(const Params& p, unsigned char* shm, int cslot) {
    float lam;
    {
        const int lane = tidx() & 63;
        float a = p.e_lam[lane] * p.e_lam[64 + lane], b = p.e_lam[128 + lane] * p.e_lam[192 + lane];
#pragma unroll
        for (int o = 32; o >= 1; o >>= 1) { a += __shfl_xor(a, o); b += __shfl_xor(b, o); }
        lam = __expf(a) - __expf(b) + 0.2f;
    }
    unsigned* counters = (unsigned*)(p.ws + OFF_CNT) + cslot * 512;
    const unsigned x0 = my_xcc();
    unsigned left = 0xffu;
    for (unsigned k = 0; k < 8; ++k) {
        const int x = (int)((x0 + k) & 7u);
        if (k == 1) left = queues_left(shm, counters, 136u);
        if (!((left >> x) & 1u)) continue;
        for (;;) {
            const int it = pop_item(shm, counters + x * 64);
            if (it >= 136) break;
            if (it < 8) scan_item<16>(p, shm, false, x, it);
            else if (it < 72) { const int j = it - 8; diff_attn_item(p, shm, false, x, j >> 4, j & 15, lam); }
            else if (it < 104) { const int j = it - 72; scan_item<8>(p, shm, true, x * 4 + (j >> 3), j & 7); }
            else { const int j = it - 104; diff_attn_item(p, shm, true, x * 4 + (j >> 3), (j >> 1) & 3, j & 1, lam); }
        }
    }
}
DI void phase_mix_odd(const Params& p, unsigned char* shm, int cslot) {
    unsigned* counters = (unsigned*)(p.ws + OFF_CNT) + 1024 + cslot * 512;
    const unsigned x0 = my_xcc();
    unsigned left = 0xffu;
    for (unsigned k = 0; k < 8; ++k) {
        const int x = (int)((x0 + k) & 7u);
        if (k == 1) left = queues_left(shm, counters, 192u);
        if (!((left >> x) & 1u)) continue;
        for (;;) {
            const int it = pop_item(shm, counters + x * 64);
            if (it >= 192) break;
            if (it < 128) win_attn_item(p, shm, false, x, it >> 3, it & 7);
            else { const int j = it - 128; win_attn_item(p, shm, true, x * 4 + (j >> 4), j & 15, 0); }
        }
    }
}

#define XB_TMO      128
#define XB_XCNT(j)  (256  + 64 * (j))
#define XB_XSUB(j)  (1280 + 64 * (j))
#define XB_XGEN(j)  (2304 + 64 * (j))
#define XB_TOP      3328
#define XB_TOPGEN   3392
#define XCD_BAR_WORDS 3456
#define XB_SPIN_CAP (1u << 18)
#define LAS __attribute__((address_space(3)))
DI unsigned xb_ld(unsigned* p)              { return __hip_atomic_load(p, __ATOMIC_RELAXED, __HIP_MEMORY_SCOPE_AGENT); }
DI unsigned xb_add(unsigned* p, unsigned v) { return __hip_atomic_fetch_add(p, v, __ATOMIC_RELAXED, __HIP_MEMORY_SCOPE_AGENT); }
DI unsigned xb_xcc_id() { return (unsigned)__builtin_amdgcn_s_getreg((3 << 11) | 20) & 0xFu; }
#define XB_SPIN(cond, bar) do { unsigned _sp = 0; while (cond) { __builtin_amdgcn_s_sleep(1); \
    if ((++_sp & 255u) == 0u) { if (xb_ld(&(bar)[XB_TMO])) break; if (_sp > XB_SPIN_CAP) { atomicAdd(&(bar)[XB_TMO], 1u); break; } } } } while (0)
struct XcdBarrier { unsigned* bar; unsigned x; volatile LAS unsigned* st; };
DI XcdBarrier xcd_barrier_post(unsigned* bar, volatile LAS unsigned* st) {
    XcdBarrier b; b.bar = bar; b.x = xb_xcc_id(); b.st = st;
    if (threadIdx.x == 0) (void)xb_add(&bar[XB_XCNT(b.x)], 1u);
    return b;
}
DI void xcd_barrier_complete(unsigned* bar, unsigned x, unsigned& nloc, unsigned& nx) {
    const unsigned G = gridDim.x * gridDim.y * gridDim.z;
    unsigned sum, cnt, mine, sp = 0u;
    for (;;) {
        sum = 0u; cnt = 0u; mine = 0u;
#pragma unroll
        for (unsigned j = 0; j < 16; ++j) { const unsigned c = xb_ld(&bar[XB_XCNT(j)]); sum += c; cnt += (c > 0u) ? 1u : 0u; mine = (j == x) ? c : mine; }
        if (sum == G) break;
        __builtin_amdgcn_s_sleep(1);
        if ((++sp & 255u) == 0u) { if (xb_ld(&bar[XB_TMO])) break; if (sp > XB_SPIN_CAP) { atomicAdd(&bar[XB_TMO], 1u); break; } }
    }
    nloc = mine > 0u ? mine : 1u; nx = cnt > 0u ? cnt : 1u;
}
DI void xcd_barrier(const XcdBarrier& b) {
    asm volatile("s_waitcnt vmcnt(0)" ::: "memory");
    __syncthreads();
    if (threadIdx.x == 0) {
        unsigned* bar = b.bar;
        __builtin_amdgcn_s_waitcnt(0);
        unsigned nloc = b.st[0], nx = b.st[1];
        if (nloc == 0u) { xcd_barrier_complete(bar, b.x, nloc, nx); b.st[0] = nloc; b.st[1] = nx; }
        const unsigned old = xb_add(&bar[XB_XSUB(b.x)], 1u);
        const unsigned gen = old / nloc;
        if (old + 1u == (gen + 1u) * nloc) {
            __builtin_amdgcn_fence(__ATOMIC_RELEASE, "agent");
            asm volatile("s_waitcnt vmcnt(0)" ::: "memory");
            const unsigned og = xb_add(&bar[XB_TOP], 1u);
            const unsigned tg = og / nx;
            if (og + 1u == (tg + 1u) * nx) xb_add(&bar[XB_TOPGEN], 1u);
            else XB_SPIN(xb_ld(&bar[XB_TOPGEN]) == tg, bar);
            __builtin_amdgcn_fence(__ATOMIC_ACQUIRE, "agent");
            xb_add(&bar[XB_XGEN(b.x)], 1u);
            asm volatile("s_waitcnt vmcnt(0)" ::: "memory");
        } else {
            XB_SPIN(xb_ld(&bar[XB_XGEN(b.x)]) == gen, bar);
            __builtin_amdgcn_fence(__ATOMIC_ACQUIRE, "agent");
            asm volatile("s_waitcnt vmcnt(0)" ::: "memory");
        }
    }
    __syncthreads();
}

DI void run_phase(const Params& p, unsigned char* shm, int ph, int cslot) {
    unsigned char* ws = p.ws;
    const float* modbuf = (const float*)(ws + OFF_MOD);
    bf16_t* H = (bf16_t*)(ws + P_H);
#ifndef TESTQ
    if (ph == 0) { phase_prep(p, shm); return; }
#endif
    const int l = (ph - 1) < 12 ? 0 : 1;
    int q = ph - 1 - l * 12;
    if (l == 1 && q >= 6) q += 1;
#ifdef TESTQ
    if (q != TESTQ || l != TESTL) return;
#endif
    switch (q) {
        case 0: phase_norm(p, l, 0, l == 0); break;
        case 1: { EpiSwiglu E{(bf16_t*)(ws + P_U)}; run_gemm(shm, H, (const bf16_t*)(ws + OFF_W13 + (size_t)(l * 2 + 0) * SZ_W13), 5632, 1024, E); } break;
        case 2: { EpiResid3 E{l == 0 ? p.x_prompt : p.out, l == 0 ? p.x_sample : p.out + (size_t)MP * DM, p.out, modbuf + (size_t)l * 9 * 9216 + 2 * 1024, 0.5f, 0};
                  run_gemm_resid192(shm, (const bf16_t*)(ws + P_U), (const bf16_t*)(ws + OFF_W2 + (size_t)(l * 2 + 0) * SZ_W2), DFF, E); } break;
        case 3: phase_norm(p, l, 1, false); break;
        case 4: if (l == 0) { EpiSplit E{(bf16_t*)(ws + P_XR), (bf16_t*)(ws + P_GT), (bf16_t*)(ws + P_QKV), 512, 512, 1536, 2, 2}; run_gemm(shm, H, (const bf16_t*)(ws + OFF_EWIN), 2560, 1024, E); }
                else { EpiSplit E{(bf16_t*)(ws + P_QKV), (bf16_t*)(ws + P_QKV), (bf16_t*)(ws + P_QKV), 1536, 1536, 1536, 0, 0}; run_gemm(shm, H, (const bf16_t*)(ws + OFF_OWIN), 1536, 1024, E); } break;
        case 5: if (l == 0) phase_post_even(p, shm); else phase_post_odd(p, shm); break;
        case 6: { EpiGates E{(const bf16_t*)(ws + P_H), (_Float16*)(ws + P_LAU), (_Float16*)(ws + P_LAU + 48 * MiB), p.e_lru_ba, p.e_lru_bi, p.e_lru_lam};
                  pg8::StaticOrder S; S.init(MTOK, 2048, (int)gridDim.x, (int)blockIdx.x);
                  pg8::gemm_phase<EpiGates, pg8::StaticOrder>((PG8_LAS unsigned char*)shm, pg8::Gemm{(const bf16_t*)(ws + P_H), (const bf16_t*)(ws + OFF_WG), MTOK, 2048, 512, 2, 128}, S, E); } break;
        case 7: if (l == 0) phase_mix_even(p, shm, cslot); else phase_mix_odd(p, shm, cslot); break;
        case 8: { EpiResid3 E{p.out, p.out + (size_t)MP * DM, p.out, modbuf + (size_t)l * 9 * 9216 + 5 * 1024, 1.0f, 0};
                  run_gemm_resid192(shm, H, (const bf16_t*)(ws + (l == 0 ? OFF_EWOUT : OFF_OWOUT)), 1024, E); } break;
        case 9: phase_norm(p, l, 2, false); break;
        case 10: { EpiSwiglu E{(bf16_t*)(ws + P_U)}; run_gemm(shm, H, (const bf16_t*)(ws + OFF_W13 + (size_t)(l * 2 + 1) * SZ_W13), 5632, 1024, E); } break;
        case 11: { EpiResid3 E{p.out, p.out + (size_t)MP * DM, p.out, modbuf + (size_t)l * 9 * 9216 + 8 * 1024, 0.5f, 0};
                   run_gemm_resid192(shm, (const bf16_t*)(ws + P_U), (const bf16_t*)(ws + OFF_W2 + (size_t)(l * 2 + 1) * SZ_W2), DFF, E); } break;
        default: break;
    }
}

__global__ void __launch_bounds__(512) trunk_megakernel(Params p) {
    extern __shared__ __attribute__((aligned(16))) unsigned char shm[];
    cg::grid_group grid = cg::this_grid();
    volatile LAS unsigned* st = (volatile LAS unsigned*)(shm + LDS_BYTES);
    if (threadIdx.x == 0) { st[0] = 0u; st[1] = 0u; }
    __syncthreads();
    XcdBarrier xb = xcd_barrier_post((unsigned*)(p.ws + OFF_BAR), st);
    for (int ph = p.p0; ph < p.p1; ++ph) {
        run_phase(p, shm, ph, 0);
        if (PROBE_PH >= 0 && ph == PROBE_PH) { xcd_barrier(xb); run_phase(p, shm, ph, 1); }
        if (ph + 1 < p.p1) { if (ph == p.p0) grid.sync(); else xcd_barrier(xb); }
    }
}

extern "C" void kernel_launch(void* const* d_in, const int* in_sizes, int n_in, void* d_out, int out_size, void* d_ws, size_t ws_size, hipStream_t stream) {
    static int grid_blocks = 0;
    if (!grid_blocks) {
        int dev = 0, cus = 0, per_cu = 0;
        hipGetDevice(&dev);
        hipDeviceGetAttribute(&cus, hipDeviceAttributeMultiprocessorCount, dev);
        hipFuncSetAttribute((const void*)trunk_megakernel, hipFuncAttributeMaxDynamicSharedMemorySize, LDS_TOTAL);
        hipOccupancyMaxActiveBlocksPerMultiprocessor(&per_cu, trunk_megakernel, 512, LDS_TOTAL);
        if (per_cu < 1) per_cu = 1;
        grid_blocks = cus * per_cu;
    }
    if (ws_size < WS_NEED + MiB) {
 fprintf(stderr, "workspace too small: %zu < %zu\n", ws_size, (size_t)WS_NEED); return; }
    Params p{};
    const float** pp = (const float**)&p;
    for (int i = 0; i < 33; ++i) pp[i] = (const float*)d_in[i];
    p.out = (float*)d_out; p.ws = (unsigned char*)d_ws;
#if MULTI_LAUNCH
    for (int ph = 0; ph < NPHASE; ++ph) {
        p.p0 = ph; p.p1 = ph + 1;
        hipLaunchKernelGGL(trunk_megakernel, dim3(grid_blocks), dim3(512), LDS_TOTAL, stream, p);
    }
#else
    p.p0 = 0; p.p1 = NPHASE;
    hipMemsetAsync((unsigned char*)d_ws + OFF_CNT, 0, CNT_BYTES + XCD_BAR_WORDS * 4, stream);
    void* args[] = {&p};
    hipError_t e = hipLaunchCooperativeKernel((void*)trunk_megakernel, dim3(grid_blocks), dim3(512), args, LDS_TOTAL, stream);
    if (e != hipSuccess) fprintf(stderr, "cooperative launch failed: %s (grid %d)\n", hipGetErrorString(e), grid_blocks);
#endif
}
```

```cpp
#include <hip/hip_runtime.h>
#include <hip/hip_cooperative_groups.h>
#include <cstdio>
namespace cg = cooperative_groups;

#define DI __device__ __forceinline__
typedef unsigned short bf16_t;
typedef short bf16x8 __attribute__((ext_vector_type(8)));
typedef float f32x4 __attribute__((ext_vector_type(4)));
typedef float f32x16 __attribute__((ext_vector_type(16)));
typedef float f32x2 __attribute__((ext_vector_type(2)));
typedef __bf16 bf16x2n __attribute__((ext_vector_type(2)));
typedef unsigned u32x4 __attribute__((ext_vector_type(4)));
typedef unsigned u32x2 __attribute__((ext_vector_type(2)));
typedef _Float16 h16x4 __attribute__((ext_vector_type(4)));

#ifndef PROBE_PH
#define PROBE_PH -1
#endif
#ifndef MULTI_LAUNCH
#define MULTI_LAUNCH 0
#endif

constexpr int MTOK = 24576, MP = 8192, DM = 1024, DFF = 2816;
constexpr int NPHASE = 24;
constexpr int LDS_BYTES = 131072;
constexpr int LDS_TOTAL = LDS_BYTES + 64;
constexpr float LOG2E = 1.4426950408889634f;

constexpr size_t MiB = 1048576;
constexpr size_t OFF_W13 = 0;
constexpr size_t SZ_W13 = (size_t)5632 * 1024 * 2;
constexpr size_t OFF_W2 = OFF_W13 + 4 * SZ_W13;
constexpr size_t SZ_W2 = (size_t)1024 * 2816 * 2;
constexpr size_t OFF_EWIN = OFF_W2 + 4 * SZ_W2;
constexpr size_t OFF_EWOUT = OFF_EWIN + (size_t)2560 * 1024 * 2;
constexpr size_t OFF_OWIN = OFF_EWOUT + (size_t)1024 * 1024 * 2;
constexpr size_t OFF_OWOUT = OFF_OWIN + (size_t)1536 * 1024 * 2;
constexpr size_t OFF_WG = OFF_OWOUT + (size_t)1024 * 1024 * 2;
constexpr size_t OFF_KDC = OFF_WG + (size_t)2048 * 512 * 2;
constexpr size_t OFF_VDC = OFF_KDC + (size_t)64 * 512 * 64 * 2;
constexpr size_t OFF_KWC = OFF_VDC + (size_t)4096 * 512 * 2;
constexpr size_t OFF_VWC = OFF_KWC + (size_t)32 * 512 * 64 * 2;
constexpr size_t OFF_MOD = OFF_VWC + (size_t)2048 * 512 * 2;
constexpr size_t OFF_CNT = OFF_MOD + (size_t)2 * 9 * 9216 * 4;
constexpr size_t OFF_POOL = 93 * MiB;
constexpr size_t P_U = OFF_POOL;
constexpr size_t P_GT = OFF_POOL;
constexpr size_t P_XR = OFF_POOL + 24 * MiB;
constexpr size_t P_QKV = OFF_POOL + 48 * MiB;
constexpr size_t P_LAU = OFF_POOL + 24 * MiB;
constexpr size_t P_ATT = OFF_POOL + 120 * MiB;
constexpr size_t P_H = OFF_POOL + 192 * MiB;
constexpr size_t WS_NEED = OFF_POOL + 240 * MiB;
constexpr size_t OFF_BAR = OFF_CNT + 8192;
static_assert(OFF_BAR + 16384 <= OFF_POOL, "ws map");
constexpr size_t CNT_BYTES = 8192;

struct Params {
    const float *x_prompt, *x_sample, *cache_diff_k, *cache_diff_v, *state_lru, *cache_win_k, *cache_win_v, *c, *c_ctx, *norm_g, *w_mod, *b_mod,
        *ffn_w1, *ffn_w3, *ffn_w2, *e_w_in, *e_w_out, *e_conv_w, *e_conv_b, *e_lru_wa, *e_lru_ba, *e_lru_wi, *e_lru_bi, *e_lru_lam, *e_q_g, *e_k_g, *e_lam,
        *e_subln_g, *o_w_in, *o_w_out, *o_q_g, *o_k_g, *o_sink;
    float* out;
    unsigned char* ws;
    int p0, p1;
};

DI int tidx() { int t = threadIdx.x; asm volatile("" : "+v"(t)); return t; }
DI unsigned pack2(float lo, float hi) { f32x2 v = {lo, hi}; bf16x2n b = __builtin_convertvector(v, bf16x2n); return __builtin_bit_cast(unsigned, b); }
DI bf16_t f2bf(float f) { return (bf16_t)(pack2(f, 0.f) & 0xffffu); }
DI float bf2f(bf16_t b) { return __uint_as_float(((unsigned)b) << 16); }
DI float bflo(unsigned w) { return __uint_as_float(w << 16); }
DI float bfhi(unsigned w) { return __uint_as_float(w & 0xffff0000u); }
DI void unpack8(const u32x4 w, float (&v)[8]) { v[0] = bflo(w.x); v[1] = bfhi(w.x); v[2] = bflo(w.y); v[3] = bfhi(w.y); v[4] = bflo(w.z); v[5] = bfhi(w.z); v[6] = bflo(w.w); v[7] = bfhi(w.w); }
DI u32x4 pack8(const float (&v)[8]) { u32x4 w; w.x = pack2(v[0], v[1]); w.y = pack2(v[2], v[3]); w.z = pack2(v[4], v[5]); w.w = pack2(v[6], v[7]); return w; }
DI float sigmoid_f(float x) { return 1.f / (1.f + __expf(-x)); }
DI float fsigmoid(float x) { return __builtin_amdgcn_rcpf(1.f + __builtin_amdgcn_exp2f(-x * 1.4426950408889634f)); }
DI float silu_f(float x) { return x / (1.f + __expf(-x)); }
DI float silu_mul(float a, float b) { const float e = __builtin_amdgcn_exp2f(-a * 1.4426950408889634f); return a * b * __builtin_amdgcn_rcpf(1.f + e); }
DI float gelu_tanh(float x) { const float u = 0.7978845608028654f * (x + 0.044715f * x * x * x); return 0.5f * x * (1.f + tanhf(u)); }
DI float xhalf_max(float x) { const auto r = __builtin_amdgcn_permlane32_swap(__float_as_uint(x), __float_as_uint(x), false, false); return fmaxf(__uint_as_float(r[0]), __uint_as_float(r[1])); }
DI int mod_row(int row) { return row < MP ? 0 : 1 + ((row - MP) >> 11); }

namespace pg8 {
#define PG8_LAS __attribute__((address_space(3)))
constexpr int BM = 256, BK = 64, HALF = 128, HTB = HALF * BK * 2, STAGE_BYTES = 8 * HTB, NXCD = 8, WGM = 8;
__host__ __device__ __forceinline__ int lds_byte(int r, int c) { const int st = (r >> 4) * 2 + (c >> 5), rr = r & 15, cc = c & 31, ob = rr * 64 + cc * 2; return st * 1024 + (ob ^ (((ob >> 9) & 1) << 5)); }
__host__ __device__ __forceinline__ void stage_rc(int b, int& R, int& C) { const int st = b / 1024, sb = b % 1024, swz = sb ^ (((sb >> 9) & 1) << 5); R = (st >> 1) * 16 + swz / 64; C = (st & 1) * 32 + (swz % 64) / 2; }
__host__ __device__ __forceinline__ int perm32(int rho) { const int n = rho >> 4, i = rho & 15; return 8 * (i >> 2) + 4 * n + (i & 3); }
struct Unit { int pm, pn; };
struct Gemm { const bf16_t* A; const bf16_t* Bt; int M, N, K, nk, kdiag; };
struct StaticOrder {
    int nM, nN, nwg, G, c;
    __device__ void init(int M, int N, int G_, int c_, int bm = BM) { nM = M / bm; nN = N / BM; nwg = nM * nN; G = G_; c = c_; }
    __device__ bool next(int i, Unit& u) const {
        const long L = (long)i * G + c; if (L >= nwg) return false;
        int wgid = (int)L; { const int q = nwg / NXCD, r = nwg % NXCD, xcd = wgid % NXCD, off = wgid / NXCD; wgid = (xcd < r ? xcd * (q + 1) : r * (q + 1) + (xcd - r) * q) + off; }
        const int nig = WGM * nN, gid = wgid / nig, fm = gid * WGM, gsz = (nM - fm) < WGM ? (nM - fm) : WGM;
        u.pm = fm + ((wgid % nig) % gsz); u.pn = (wgid % nig) / gsz; return true;
    }
    __device__ __forceinline__ void a_ready(const Unit&) const {}
    __device__ __forceinline__ void done(const Unit&) const {}
};

template <class Epi, class Sched, int MREP = 4>
__device__ __forceinline__ void gemm_phase(PG8_LAS unsigned char* lds, const Gemm g, const Sched& S, const Epi& E) {
    const int tid = tidx(), wid = __builtin_amdgcn_readfirstlane(tid >> 6), lane = tid & 63, wr = wid >> 2, wc = wid & 3, fr = lane & 15, fq = lane >> 4;
    const int K = g.K, nt = g.nk ? g.nk : K / BK;
    unsigned voffA[2], voffB[2];
#pragma unroll
    for (int i = 0; i < 2; ++i) { int R, C; stage_rc(tid * 16 + i * 8192, R, C); const int Rb = Epi::PERM ? ((R & ~31) + perm32(R & 31)) : R;
        voffA[i] = (unsigned)(R * K + C) * 2u; voffB[i] = (unsigned)(Rb * K + C) * 2u; }
    const size_t kstep = (size_t)(BK * 2);
    const size_t hstep = (size_t)(32 * MREP) * K * 2;
    const size_t hstepB = (size_t)HALF * K * 2;
    const size_t tstep = 2 * hstep, tstepB = 2 * hstepB;
    const unsigned ldsw = (unsigned)wid * 1024u;
    const int aoff = lds_byte(wr * (16 * MREP) + fr, fq * 8), boff = lds_byte(wc * 32 + fr, fq * 8);
#define PG8_SA(b, h) (((b) * 2 + (h)) * HTB)
#define PG8_SB(b, h) ((4 + (b) * 2 + (h)) * HTB)
#define PG8_STAGE(bufoff, gbase, voff) do { _Pragma("unroll") for (int _i = 0; _i < 2; ++_i) \
        __builtin_amdgcn_global_load_lds((const unsigned*)((const char*)(gbase) + (voff)[_i]), (PG8_LAS unsigned*)(lds + (bufoff) + ldsw + _i * 8192), 16, 0, 0); } while (0)
#define PG8_LDA(dst, b, h) do { _Pragma("unroll") for (int m = 0; m < MREP; ++m) _Pragma("unroll") for (int k = 0; k < 2; ++k) dst[m][k] = *(const PG8_LAS bf16x8*)(lds + PG8_SA(b, h) + aoff + m * 2048 + k * 1024); } while (0)
#define PG8_LDB(dst, b, h) do { _Pragma("unroll") for (int n = 0; n < 2; ++n) _Pragma("unroll") for (int k = 0; k < 2; ++k) dst[n][k] = *(const PG8_LAS bf16x8*)(lds + PG8_SB(b, h) + boff + n * 2048 + k * 1024); } while (0)
#define PG8_MMA(ai, bj, At, Bt) do { __builtin_amdgcn_s_setprio(1); _Pragma("unroll") for (int m = 0; m < MREP; ++m) _Pragma("unroll") for (int n = 0; n < 2; ++n) _Pragma("unroll") for (int k = 0; k < 2; ++k) \
        acc[ai][bj][m][n] = __builtin_amdgcn_mfma_f32_16x16x32_bf16(Bt[n][k], At[m][k], acc[ai][bj][m][n], 0, 0, 0); __builtin_amdgcn_s_setprio(0); } while (0)
#define PG8_WAIT_V(n) asm volatile("s_waitcnt vmcnt(" #n ")" ::: "memory")
#define PG8_WAIT_L(n) asm volatile("s_waitcnt lgkmcnt(" #n ")" ::: "memory")
#define PG8_BAR __builtin_amdgcn_s_barrier()
#define PG8_SCHED __builtin_amdgcn_sched_barrier(0)
    Unit cur, nxt; int ui = 0;
    if (!S.next(0, cur)) return;
    f32x4 acc[2][2][MREP][2];
#pragma unroll
    for (int a = 0; a < 2; ++a)
#pragma unroll
        for (int b = 0; b < 2; ++b)
#pragma unroll
            for (int m = 0; m < MREP; ++m)
#pragma unroll
                for (int n = 0; n < 2; ++n) acc[a][b][m][n] = (f32x4){0.f, 0.f, 0.f, 0.f};
    bf16x8 At[MREP][2], B0[2][2], B1[2][2];
    const char* cA = (const char*)g.A + (size_t)cur.pm * tstep + (size_t)(g.kdiag * (cur.pn & 3)) * 2; const char* cB = (const char*)g.Bt + (size_t)cur.pn * tstepB + (size_t)(g.kdiag * (cur.pn & 3)) * 2;
    S.a_ready(cur);
    PG8_STAGE(PG8_SB(0, 0), cB, voffB); PG8_STAGE(PG8_SA(0, 0), cA, voffA); PG8_STAGE(PG8_SB(0, 1), cB + hstepB, voffB); PG8_STAGE(PG8_SA(0, 1), cA + hstep, voffA);
    if (wr == 1) PG8_BAR;
    PG8_WAIT_V(4); PG8_BAR;
    PG8_STAGE(PG8_SB(1, 0), cB + kstep, voffB); PG8_STAGE(PG8_SA(1, 0), cA + kstep, voffA); PG8_STAGE(PG8_SB(1, 1), cB + hstepB + kstep, voffB);
    PG8_WAIT_V(6); PG8_BAR;
    for (;;) {
        const bool has_next = S.next(ui + 1, nxt);
        const char* nA = has_next ? (const char*)g.A + (size_t)nxt.pm * tstep + (size_t)(g.kdiag * (nxt.pn & 3)) * 2 : cA; const char* nB = has_next ? (const char*)g.Bt + (size_t)nxt.pn * tstepB + (size_t)(g.kdiag * (nxt.pn & 3)) * 2 : cB;
        for (int t = 0; t < nt; t += 2) {
            const bool last = (t == nt - 2);
            const char* a1 = cA + (size_t)(t + 1) * kstep;
            const char* a2 = last ? nA : cA + (size_t)(t + 2) * kstep; const char* b2 = last ? nB : cB + (size_t)(t + 2) * kstep;
            const char* a3 = a2 + kstep; const char* b3 = b2 + kstep;
            if (last && has_next) S.a_ready(nxt);
            PG8_LDB(B0, 0, 0); PG8_SCHED; PG8_LDA(At, 0, 0); PG8_STAGE(PG8_SA(1, 1), a1 + hstep, voffA);
            if constexpr (MREP == 4) PG8_WAIT_L(8); else PG8_WAIT_L(6); PG8_BAR; PG8_WAIT_L(0); PG8_MMA(0, 0, At, B0); PG8_BAR; PG8_SCHED;
            PG8_LDB(B1, 0, 1); PG8_STAGE(PG8_SB(0, 0), b2, voffB);
            PG8_BAR; PG8_WAIT_L(0); PG8_MMA(0, 1, At, B1); PG8_BAR;
            PG8_LDA(At, 0, 1); PG8_STAGE(PG8_SA(0, 0), a2, voffA);
            PG8_BAR; PG8_WAIT_L(0); PG8_MMA(1, 0, At, B0); PG8_BAR; PG8_SCHED;
            PG8_STAGE(PG8_SB(0, 1), b2 + hstepB, voffB);
            PG8_WAIT_V(6); PG8_BAR; PG8_MMA(1, 1, At, B1); PG8_BAR;
            PG8_LDB(B0, 1, 0); PG8_SCHED; PG8_LDA(At, 1, 0); PG8_STAGE(PG8_SA(0, 1), a2 + hstep, voffA);
            if constexpr (MREP == 4) PG8_WAIT_L(8); else PG8_WAIT_L(6); PG8_BAR; PG8_WAIT_L(0); PG8_MMA(0, 0, At, B0); PG8_BAR; PG8_SCHED;
            PG8_LDB(B1, 1, 1); PG8_STAGE(PG8_SB(1, 0), b3, voffB);
            PG8_BAR; PG8_WAIT_L(0); PG8_MMA(0, 1, At, B1); PG8_BAR;
            PG8_LDA(At, 1, 1); PG8_STAGE(PG8_SA(1, 0), a3, voffA);
            PG8_BAR; PG8_WAIT_L(0); PG8_MMA(1, 0, At, B0); PG8_BAR; PG8_SCHED;
            PG8_STAGE(PG8_SB(1, 1), b3 + hstepB, voffB);
            PG8_WAIT_V(6); PG8_BAR; PG8_MMA(1, 1, At, B1); PG8_BAR;
        }
        E(acc, cur, wr, wc, fr, fq); S.done(cur);
        if (!has_next) break;
#pragma unroll
        for (int a = 0; a < 2; ++a)
#pragma unroll
            for (int b = 0; b < 2; ++b)
#pragma unroll
                for (int m = 0; m < MREP; ++m)
#pragma unroll
                    for (int n = 0; n < 2; ++n) acc[a][b][m][n] = (f32x4){0.f, 0.f, 0.f, 0.f};
        cur = nxt; cA = nA; cB = nB; ++ui;
    }
    PG8_WAIT_V(0);
    if (wr == 0) PG8_BAR;
    PG8_BAR;
#undef PG8_SA
#undef PG8_SB
#undef PG8_STAGE
#undef PG8_LDA
#undef PG8_LDB
#undef PG8_MMA
#undef PG8_WAIT_V
#undef PG8_WAIT_L
#undef PG8_BAR
#undef PG8_SCHED
}
}
using pg8::Unit;

struct EpiSwiglu {
    static constexpr bool PERM = true;
    bf16_t* U;
    DI void operator()(const f32x4 (&acc)[2][2][4][2], const Unit& u, int wr, int wc, int fr, int fq) const {
        asm volatile("" : "+v"(fr), "+v"(fq));
        const int row0 = u.pm * 256 + wr * 64 + fr, col0 = u.pn * 128 + wc * 32 + 8 * fq;
#pragma unroll
        for (int ai = 0; ai < 2; ++ai)
#pragma unroll
            for (int m = 0; m < 4; ++m) {
                bf16_t* rowp = U + (size_t)(row0 + ai * 128 + m * 16) * DFF + col0;
                float v[8];
#pragma unroll
                for (int n = 0; n < 2; ++n)
#pragma unroll
                    for (int j = 0; j < 4; ++j) v[n * 4 + j] = silu_mul(acc[ai][0][m][n][j], acc[ai][1][m][n][j]);
                *(u32x4*)rowp = pack8(v);
            }
    }
};
struct EpiResid {
    static constexpr bool PERM = false;
    const float* xp; const float* xs; float* out; const float* gate; float coef;
    DI void operator()(const f32x4 (&acc)[2][2][4][2], const Unit& u, int wr, int wc, int fr, int fq) const {
        asm volatile("" : "+v"(fr), "+v"(fq));
        const int rowt = u.pm * 256;
        const float* gp = gate + (size_t)mod_row(rowt) * 9216;
        const float* src = rowt < MP ? xp + (size_t)rowt * DM : xs + (size_t)(rowt - MP) * DM;
        float* dst = out + (size_t)rowt * DM;
        const int r0 = wr * 64 + fr, col0 = u.pn * 256 + wc * 32 + 4 * fq;
#pragma unroll
        for (int bj = 0; bj < 2; ++bj)
#pragma unroll
            for (int n = 0; n < 2; ++n) {
                const int cc = col0 + bj * 128 + n * 16;
                f32x4 xv[2][4];
#pragma unroll
                for (int ai = 0; ai < 2; ++ai)
#pragma unroll
                    for (int m = 0; m < 4; ++m) xv[ai][m] = *(const f32x4*)(src + (size_t)(r0 + ai * 128 + m * 16) * DM + cc);
                const f32x4 gv = *(const f32x4*)(gp + cc) * coef;
#pragma unroll
                for (int ai = 0; ai < 2; ++ai)
#pragma unroll
                    for (int m = 0; m < 4; ++m) *(f32x4*)(dst + (size_t)(r0 + ai * 128 + m * 16) * DM + cc) = xv[ai][m] + gv * acc[ai][bj][m][n];
            }
    }
};
struct EpiResid3 {
    static constexpr bool PERM = false;
    const float* xp; const float* xs; float* out; const float* gate; float coef; int pad_;
    DI void operator()(const f32x4 (&acc)[2][2][3][2], const Unit& u, int wr, int wc, int fr, int fq) const {
        asm volatile("" : "+v"(fr), "+v"(fq));
        const int rowt = u.pm * 192, rowb = rowt + wr * 48 + fr, col0 = u.pn * 256 + wc * 32 + 4 * fq;
        const int mr0 = mod_row(rowt);
        if (mr0 == mod_row(rowt + 191)) {
            const float* gp = gate + (size_t)mr0 * 9216;
            const float* src = rowt < MP ? xp : xs - (size_t)MP * DM;
#pragma unroll
            for (int bj = 0; bj < 2; ++bj)
#pragma unroll
                for (int n = 0; n < 2; ++n) {
                    const int cc = col0 + bj * 128 + n * 16;
                    f32x4 xv[2][3];
#pragma unroll
                    for (int ai = 0; ai < 2; ++ai)
#pragma unroll
                        for (int m = 0; m < 3; ++m) xv[ai][m] = *(const f32x4*)(src + (size_t)(rowb + ai * 96 + m * 16) * DM + cc);
                    const f32x4 gv = *(const f32x4*)(gp + cc) * coef;
#pragma unroll
                    for (int ai = 0; ai < 2; ++ai)
#pragma unroll
                        for (int m = 0; m < 3; ++m) *(f32x4*)(out + (size_t)(rowb + ai * 96 + m * 16) * DM + cc) = xv[ai][m] + gv * acc[ai][bj][m][n];
                }
        } else {
#pragma unroll
            for (int bj = 0; bj < 2; ++bj)
#pragma unroll
                for (int n = 0; n < 2; ++n) {
                    const int cc = col0 + bj * 128 + n * 16;
                    f32x4 xv[2][3], gv[2][3];
#pragma unroll
                    for (int ai = 0; ai < 2; ++ai)
#pragma unroll
                        for (int m = 0; m < 3; ++m) {
                            const int row = rowb + ai * 96 + m * 16;
                            const float* src = row < MP ? xp + (size_t)row * DM : xs + (size_t)(row - MP) * DM;
                            xv[ai][m] = *(const f32x4*)(src + cc);
                            gv[ai][m] = *(const f32x4*)(gate + (size_t)mod_row(row) * 9216 + cc);
                        }
#pragma unroll
                    for (int ai = 0; ai < 2; ++ai)
#pragma unroll
                        for (int m = 0; m < 3; ++m) {
                            const int row = rowb + ai * 96 + m * 16;
                            *(f32x4*)(out + (size_t)row * DM + cc) = xv[ai][m] + gv[ai][m] * coef * acc[ai][bj][m][n];
                        }
                }
        }
    }
};
struct EpiSplit {
    static constexpr bool PERM = true;
    bf16_t* b0; bf16_t* b1; bf16_t* b2; int ld0, ld1, ld2, n0, n1;
    DI void operator()(const f32x4 (&acc)[2][2][4][2], const Unit& u, int wr, int wc, int fr, int fq) const {
        asm volatile("" : "+v"(fr), "+v"(fq));
        bf16_t* base; int ld, ct;
        if (u.pn < n0) { base = b0; ld = ld0; ct = u.pn; } else if (u.pn < n0 + n1) { base = b1; ld = ld1; ct = u.pn - n0; } else { base = b2; ld = ld2; ct = u.pn - n0 - n1; }
        const int row0 = u.pm * 256 + wr * 64 + fr, col0 = ct * 256 + wc * 32 + 8 * fq;
#pragma unroll
        for (int ai = 0; ai < 2; ++ai)
#pragma unroll
            for (int m = 0; m < 4; ++m) {
                bf16_t* rowp = base + (size_t)(row0 + ai * 128 + m * 16) * ld + col0;
#pragma unroll
                for (int bj = 0; bj < 2; ++bj) {
                    u32x4 w; w.x = pack2(acc[ai][bj][m][0][0], acc[ai][bj][m][0][1]); w.y = pack2(acc[ai][bj][m][0][2], acc[ai][bj][m][0][3]);
                    w.z = pack2(acc[ai][bj][m][1][0], acc[ai][bj][m][1][1]); w.w = pack2(acc[ai][bj][m][1][2], acc[ai][bj][m][1][3]);
                    *(u32x4*)(rowp + bj * 128) = w;
                }
            }
    }
};
struct EpiGates {
    static constexpr bool PERM = false;
    const bf16_t* xc; _Float16* la; _Float16* uu; const float* ba; const float* bi; const float* lam;
    DI void operator()(const f32x4 (&acc)[2][2][4][2], const Unit& u, int wr, int wc, int fr, int fq) const {
        asm volatile("" : "+v"(fr), "+v"(fq));
        const int dir = u.pn >> 2, cgp = u.pn & 3;
        const int ch0 = cgp * 128 + wc * 32 + 4 * fq;
        _Float16* lad = la + (size_t)dir * MTOK * 512; _Float16* ud = uu + (size_t)dir * MTOK * 512;
#pragma unroll
        for (int n = 0; n < 2; ++n) {
            const int ch = ch0 + n * 16;
            float bav[4], biv[4], spv[4];
#pragma unroll
            for (int j = 0; j < 4; ++j) { const int cx = dir * 512 + ch + j; bav[j] = ba[cx]; biv[j] = bi[cx]; const float lm = lam[cx]; spv[j] = (lm < -15.f) ? -lm : log1pf(__expf(-lm)); }
            u32x2 xw[2][4];
#pragma unroll
            for (int ai = 0; ai < 2; ++ai)
#pragma unroll
                for (int m = 0; m < 4; ++m) xw[ai][m] = *(const u32x2*)(xc + (size_t)(u.pm * 256 + ai * 128 + wr * 64 + m * 16 + fr) * 512 + ch);
#pragma unroll
            for (int ai = 0; ai < 2; ++ai)
#pragma unroll
                for (int m = 0; m < 4; ++m) {
                    const size_t r = (size_t)(u.pm * 256 + ai * 128 + wr * 64 + m * 16 + fr);
                    const float xv[4] = {bflo(xw[ai][m].x), bfhi(xw[ai][m].x), bflo(xw[ai][m].y), bfhi(xw[ai][m].y)};
                    h16x4 lo, uo;
#pragma unroll
                    for (int j = 0; j < 4; ++j) {
                        const float rr = fsigmoid(acc[ai][0][m][n][j] + bav[j]), ii = fsigmoid(acc[ai][1][m][n][j] + biv[j]);
                        const float lg = -8.f * rr * spv[j];
                        lo[j] = (_Float16)lg; uo[j] = (_Float16)(ii * xv[j]);
                    }
                    *(h16x4*)(lad + r * 512 + ch) = lo; *(h16x4*)(ud + r * 512 + ch) = uo;
                }
        }
    }
};

template <class Epi>
DI void run_gemm(unsigned char* shm, const bf16_t* A, const bf16_t* Bt, int N, int K, const Epi& E) {
    pg8::StaticOrder S; S.init(MTOK, N, (int)gridDim.x, (int)blockIdx.x);
    pg8::gemm_phase<Epi, pg8::StaticOrder>((PG8_LAS unsigned char*)shm, pg8::Gemm{A, Bt, MTOK, N, K, 0, 0}, S, E);
}

DI void run_gemm_resid192(unsigned char* shm, const bf16_t* A, const bf16_t* Bt, int K, const EpiResid3& E) {
    pg8::StaticOrder S; S.init(MTOK, 1024, (int)gridDim.x, (int)blockIdx.x, 192);
    pg8::gemm_phase<EpiResid3, pg8::StaticOrder, 3>((PG8_LAS unsigned char*)shm, pg8::Gemm{A, Bt, MTOK, 1024, K, 0, 0}, S, E);
}

DI void transpose_tile(const float* __restrict__ src, int lds_, int k0, int n0, bf16_t* __restrict__ dst, int ldd, int drow0, int mode, float*) {
    const int tid = tidx(), lane = tid & 63, w = tid >> 6, kb = lane & 7, ng = lane >> 3;
    const int c = 32 * w + 4 * ng;
    const float* sp = src + (size_t)(k0 + 8 * kb) * lds_ + n0 + c;
    float4 v[8];
#pragma unroll
    for (int j = 0; j < 8; ++j) { const f32x4 t = __builtin_nontemporal_load((const f32x4*)(sp + (size_t)j * lds_)); v[j] = make_float4(t[0], t[1], t[2], t[3]); }
    const float x[4][8] = {{v[0].x, v[1].x, v[2].x, v[3].x, v[4].x, v[5].x, v[6].x, v[7].x}, {v[0].y, v[1].y, v[2].y, v[3].y, v[4].y, v[5].y, v[6].y, v[7].y},
                           {v[0].z, v[1].z, v[2].z, v[3].z, v[4].z, v[5].z, v[6].z, v[7].z}, {v[0].w, v[1].w, v[2].w, v[3].w, v[4].w, v[5].w, v[6].w, v[7].w}};
#pragma unroll
    for (int q = 0; q < 4; ++q) {
        const int cc = c + q;
        const int drow = mode ? drow0 + 256 * (cc >> 7) + (cc & 127) : drow0 + cc;
        *(u32x4*)(dst + (size_t)drow * ldd + k0 + 8 * kb) = pack8(x[q]);
    }
}

DI void phase_prep(const Params& p, unsigned char* shm) {
    const int tid = tidx();
    unsigned char* ws = p.ws;
    float* s_silu = (float*)shm;
    float* red = (float*)(shm + 36864);
    float* tile = (float*)(shm + 36864 + 18432);
    if (blockIdx.x == 0) for (int i = tid; i < (int)(CNT_BYTES / 4); i += 512) ((unsigned*)(ws + OFF_CNT))[i] = 0u;
    for (int i = tid; i < 9216; i += 512) { const int r = i >> 10, k = i & 1023; const float v = r == 0 ? p.c_ctx[k] : p.c[(r - 1) * 1024 + k]; s_silu[i] = silu_f(v); }
    __syncthreads();
    constexpr int N_MOD_IT = 576, N_TR = 2688, N_CK = 768, N_WG = 256;
    constexpr int TOTAL = N_MOD_IT + N_TR + N_CK + N_WG;
    float* modbuf = (float*)(ws + OFF_MOD);
    for (int item = blockIdx.x; item < TOTAL; item += gridDim.x) {
        if (item < N_MOD_IT) {
            const int l = item / 288, col0 = (item % 288) * 32, c = tid & 31, kg = tid >> 5;
            float acc[9];
#pragma unroll
            for (int r = 0; r < 9; ++r) acc[r] = 0.f;
            const float* wp = p.w_mod + (size_t)l * 1024 * 9216 + (size_t)(kg * 64) * 9216 + col0 + c;
            for (int k = 0; k < 64; k += 16) {
                float w[16];
#pragma unroll
                for (int q = 0; q < 16; ++q) w[q] = __builtin_nontemporal_load(wp + (size_t)(k + q) * 9216);
#pragma unroll
                for (int q = 0; q < 16; ++q)
#pragma unroll
                    for (int r = 0; r < 9; ++r) acc[r] += s_silu[r * 1024 + kg * 64 + k + q] * w[q];
            }
#pragma unroll
            for (int r = 0; r < 9; ++r) red[(kg * 9 + r) * 32 + c] = acc[r];
            __syncthreads();
            if (tid < 288) {
                const int r = tid >> 5, cc = tid & 31; float sacc = 0.f;
#pragma unroll
                for (int g = 0; g < 16; ++g) sacc += red[(g * 9 + r) * 32 + cc];
                modbuf[(size_t)(l * 9 + r) * 9216 + col0 + cc] = sacc + p.b_mod[l * 9216 + col0 + cc];
            }
            __syncthreads();
        } else if (item < N_MOD_IT + N_TR) {
            int t = item - N_MOD_IT;
            if (t < 2112) {
                const int ls = t / 528, r = t % 528, which = r / 176, tt = r % 176;
                if (which < 2) {
                    const float* src = (which == 0 ? p.ffn_w1 : p.ffn_w3) + (size_t)ls * 1024 * DFF;
                    const int kt = tt / 11, n0 = (tt % 11) * 256;
                    transpose_tile(src, DFF, kt * 64, n0, (bf16_t*)(ws + OFF_W13 + ls * SZ_W13), 1024, 2 * n0 + which * 128, 1, tile);
                } else {
                    const float* src = p.ffn_w2 + (size_t)ls * DFF * 1024;
                    const int kt = tt / 4, n0 = (tt % 4) * 256;
                    transpose_tile(src, 1024, kt * 64, n0, (bf16_t*)(ws + OFF_W2 + ls * SZ_W2), DFF, n0, 0, tile);
                }
            } else if ((t -= 2112) < 160) { transpose_tile(p.e_w_in, 2560, (t / 10) * 64, (t % 10) * 256, (bf16_t*)(ws + OFF_EWIN), 1024, (t % 10) * 256, 0, tile); }
            else if ((t -= 160) < 64) { transpose_tile(p.e_w_out, 1024, (t / 4) * 64, (t % 4) * 256, (bf16_t*)(ws + OFF_EWOUT), 1024, (t % 4) * 256, 0, tile); }
            else if ((t -= 64) < 96) { transpose_tile(p.o_w_in, 1536, (t / 6) * 64, (t % 6) * 256, (bf16_t*)(ws + OFF_OWIN), 1024, (t % 6) * 256, 0, tile); }
            else if ((t -= 96) < 64) { transpose_tile(p.o_w_out, 1024, (t / 4) * 64, (t % 4) * 256, (bf16_t*)(ws + OFF_OWOUT), 1024, (t % 4) * 256, 0, tile); }
            else if ((t -= 64) < 128) {
                const int b = t / 16, r = t % 16;
                transpose_tile(p.cache_diff_v + (size_t)b * 512 * 512, 512, (r / 2) * 64, (r % 2) * 256, (bf16_t*)(ws + OFF_VDC), 512, b * 512 + (r % 2) * 256, 0, tile);
            } else { t -= 128;
                const int b = t / 8, r = t % 8;
                transpose_tile(p.cache_win_v + (size_t)b * 512 * 256, 256, r * 64, 0, (bf16_t*)(ws + OFF_VWC), 512, b * 256, 0, tile);
            }
        } else if (item < N_MOD_IT + N_TR + N_CK) {
            const int j = item - N_MOD_IT - N_TR;
            if (j < 512) {
                const int ch = j * 512 + tid, d8 = ch & 7, m = (ch >> 3) & 1, h = (ch >> 4) & 3, t = (ch >> 6) & 511, b = ch >> 15;
                const float* s = p.cache_diff_k + (size_t)ch * 8; float v[8];
                const f32x4 a = __builtin_nontemporal_load((const f32x4*)s), bq = __builtin_nontemporal_load((const f32x4*)(s + 4)); v[0] = a[0]; v[1] = a[1]; v[2] = a[2]; v[3] = a[3]; v[4] = bq[0]; v[5] = bq[1]; v[6] = bq[2]; v[7] = bq[3];
                *(u32x4*)((bf16_t*)(ws + OFF_KDC) + ((size_t)(((b * 4 + h) * 2 + m) * 512 + t)) * 64 + d8 * 8) = pack8(v);
            } else {
                const int ch = (j - 512) * 512 + tid, d8 = ch & 7, kv = (ch >> 3) & 3, t = (ch >> 5) & 511, b = ch >> 14;
                const float* s = p.cache_win_k + (size_t)ch * 8; float v[8];
                const f32x4 a = __builtin_nontemporal_load((const f32x4*)s), bq = __builtin_nontemporal_load((const f32x4*)(s + 4)); v[0] = a[0]; v[1] = a[1]; v[2] = a[2]; v[3] = a[3]; v[4] = bq[0]; v[5] = bq[1]; v[6] = bq[2]; v[7] = bq[3];
                *(u32x4*)((bf16_t*)(ws + OFF_KWC) + ((size_t)((b * 4 + kv) * 512 + t)) * 64 + d8 * 8) = pack8(v);
            }
        } else {
            const int j = item - N_MOD_IT - N_TR - N_CK;
            const int ch_ = j * 512 + tid, nrow = ch_ >> 6, k8 = (ch_ & 63) * 8;
            const int pn = nrow >> 8, bj = (nrow >> 7) & 1, cp = nrow & 127, dir = pn >> 2, ch = (pn & 3) * 128 + cp, n = ch >> 6, jj = ch & 63;
            float v[8];
#pragma unroll
            for (int q = 0; q < 8; ++q) v[q] = 0.f;
            if ((k8 >> 6) == n) {
                const float* W = (bj ? p.e_lru_wi : p.e_lru_wa) + (size_t)((dir * 8 + n) * 64 + (k8 & 63)) * 64 + jj;
#pragma unroll
                for (int q = 0; q < 8; ++q) v[q] = W[q * 64];
            }
            *(u32x4*)((bf16_t*)(ws + OFF_WG) + (size_t)nrow * 512 + k8) = pack8(v);
        }
    }
}

DI void phase_norm(const Params& p, int l, int which, bool first) {
    const int tid = tidx(), lane = tid & 63, wid = tid >> 6;
    const float* g = p.norm_g + (l * 3 + which) * DM;
    const float* modbuf = (const float*)(p.ws + OFF_MOD);
    bf16_t* H = (bf16_t*)(p.ws + P_H);
    auto issue = [&](int g4, float4 (&v)[4][4]) __attribute__((always_inline)) {
        const int row = g4 * 4;
        const float* xr = first ? (row < MP ? p.x_prompt + (size_t)row * DM : p.x_sample + (size_t)(row - MP) * DM) : p.out + (size_t)row * DM;
#pragma unroll
        for (int rr = 0; rr < 4; ++rr)
#pragma unroll
            for (int i = 0; i < 4; ++i) v[rr][i] = *(const float4*)(xr + (size_t)rr * DM + i * 256 + lane * 4);
    };
    float4 v[4][4], vn[4][4];
    if ((int)blockIdx.x * 8 + wid < MTOK / 4) issue((int)blockIdx.x * 8 + wid, v);
    for (int g4 = blockIdx.x * 8 + wid; g4 < MTOK / 4; g4 += gridDim.x * 8) {
        const int row = g4 * 4;
        const float* sh = modbuf + (size_t)(l * 9 + mod_row(row)) * 9216 + which * 3 * 1024;
        const float* sc = sh + 1024;
        const bool more = g4 + (int)gridDim.x * 8 < MTOK / 4;
        if (more) issue(g4 + (int)gridDim.x * 8, vn);
        float ss[4];
#pragma unroll
        for (int rr = 0; rr < 4; ++rr) ss[rr] = 0.f;
#pragma unroll
        for (int rr = 0; rr < 4; ++rr)
#pragma unroll
            for (int i = 0; i < 4; ++i) ss[rr] += v[rr][i].x * v[rr][i].x + v[rr][i].y * v[rr][i].y + v[rr][i].z * v[rr][i].z + v[rr][i].w * v[rr][i].w;
#pragma unroll
        for (int o = 32; o >= 1; o >>= 1) {
#pragma unroll
            for (int rr = 0; rr < 4; ++rr) ss[rr] += __shfl_xor(ss[rr], o);
        }
        float rs[4];
#pragma unroll
        for (int rr = 0; rr < 4; ++rr) rs[rr] = rsqrtf(ss[rr] * (1.f / 1024.f) + 1e-6f);
#pragma unroll
        for (int i = 0; i < 4; ++i) {
            const int col = i * 256 + lane * 4;
            const float4 g4v = *(const float4*)(g + col), s4 = *(const float4*)(sc + col), h4 = *(const float4*)(sh + col);
            const float mx = g4v.x * (1.f + s4.x), my = g4v.y * (1.f + s4.y), mz = g4v.z * (1.f + s4.z), mw = g4v.w * (1.f + s4.w);
#pragma unroll
            for (int rr = 0; rr < 4; ++rr) {
                u32x2 w;
                w.x = pack2(v[rr][i].x * rs[rr] * mx + h4.x, v[rr][i].y * rs[rr] * my + h4.y);
                w.y = pack2(v[rr][i].z * rs[rr] * mz + h4.z, v[rr][i].w * rs[rr] * mw + h4.w);
                *(u32x2*)(H + (size_t)(row + rr) * DM + col) = w;
            }
        }
        if (more) {
#pragma unroll
            for (int rr = 0; rr < 4; ++rr)
#pragma unroll
                for (int i = 0; i < 4; ++i) v[rr][i] = vn[rr][i];
        }
    }
}

DI void qk_norm_rope(float (&v)[8], const float* g8, bool rope, const float (&cs)[8], const float (&sn)[8], int lane) {
    float ss = 0.f;
#pragma unroll
    for (int j = 0; j < 8; ++j) ss += v[j] * v[j];
    ss += __shfl_xor(ss, 1); ss += __shfl_xor(ss, 2); ss += __shfl_xor(ss, 4);
    const float rs = rsqrtf(ss * (1.f / 64.f) + 1e-6f);
#pragma unroll
    for (int j = 0; j < 8; ++j) v[j] = v[j] * rs * g8[j];
    float pv[8];
#pragma unroll
    for (int j = 0; j < 8; ++j) pv[j] = __shfl_xor(v[j], 2);
    if (rope) {
        const bool lowhalf = ((lane & 2) == 0);
#pragma unroll
        for (int j = 0; j < 8; ++j) v[j] = lowhalf ? (v[j] * cs[j] - pv[j] * sn[j]) : (v[j] * cs[j] + pv[j] * sn[j]);
    }
}
DI void rope_table_fill(float* T) {
    for (int idx = tidx(); idx < 1024; idx += 512) {
        const int pos = idx >> 4, fi = idx & 15;
        const float inv = exp2f(-(float)(2 * fi) * (13.287712379549449f / 32.f));
        float sv, cv; sincosf((float)pos * inv, &sv, &cv);
        T[idx * 2] = cv; T[idx * 2 + 1] = sv;
    }
    __syncthreads();
}
DI void rope_tables(const float* T, int s, int lane, float (&cs)[8], float (&sn)[8]) {
    const int d0 = (lane & 7) * 8;
    const int pos = (d0 < 32) ? (s >> 6) : (s & 63);
    const float4* tp = (const float4*)(T + ((pos << 4) + (d0 & 15)) * 2);
#pragma unroll
    for (int j = 0; j < 4; ++j) { const float4 v = tp[j]; cs[2 * j] = v.x; sn[2 * j] = v.y; cs[2 * j + 1] = v.z; sn[2 * j + 1] = v.w; }
}
DI void ld8(const bf16_t* p, float (&v)[8]) { unpack8(*(const u32x4*)p, v); }
DI void st8f(float* p, const float (&v)[8]) {
    const f32x4 a = {v[0], v[1], v[2], v[3]}, b = {v[4], v[5], v[6], v[7]};
    __builtin_nontemporal_store(a, (f32x4*)p); __builtin_nontemporal_store(b, (f32x4*)(p + 4)); }

DI void phase_post_even(const Params& p, unsigned char* shm) {
    const int tid = tidx(), lane = tid & 63, wid = tid >> 6;
    unsigned char* ws = p.ws;
    const bf16_t* XR = (const bf16_t*)(ws + P_XR); const bf16_t* QKV = (const bf16_t*)(ws + P_QKV);
    bf16_t* Qd = (bf16_t*)(ws + P_ATT); bf16_t* Kd = (bf16_t*)(ws + P_ATT + 24 * MiB); bf16_t* Vtd = (bf16_t*)(ws + P_ATT + 48 * MiB);
    bf16_t* xc = (bf16_t*)(ws + P_H);
    float* o_dk = p.out + (size_t)MTOK * DM; float* o_dv = o_dk + (size_t)MP * 512;
    bf16_t* svt = (bf16_t*)shm;
    float* ropeT = (float*)(shm + 16384); rope_table_fill(ropeT);
    float gq[8], gk[8], cw[4][8], cb[8];
#pragma unroll
    for (int j = 0; j < 8; ++j) { gq[j] = p.e_q_g[(lane & 7) * 8 + j]; gk[j] = p.e_k_g[(lane & 7) * 8 + j]; cb[j] = p.e_conv_b[lane * 8 + j];
#pragma unroll
        for (int t = 0; t < 4; ++t) cw[t][j] = p.e_conv_w[t * 512 + lane * 8 + j]; }
    auto issue = [&](int it, u32x4& wq, u32x4& wk, u32x4& wv, u32x4 (&wx)[4]) __attribute__((always_inline)) {
        const int row = it * 8 + wid; const bool prm = row < MP; const int S = prm ? 256 : 2048, s = prm ? (row & 255) : ((row - MP) & 2047);
        const bf16_t* zr = QKV + (size_t)row * 1536;
        wq = *(const u32x4*)(zr + lane * 8); wk = *(const u32x4*)(zr + 512 + lane * 8); wv = *(const u32x4*)(zr + 1024 + lane * 8);
#pragma unroll
        for (int t = 0; t < 4; ++t) { const int sp = s + t - 2; const int rr = (sp >= 0 && sp < S) ? row + t - 2 : row; wx[t] = *(const u32x4*)(XR + (size_t)rr * 512 + lane * 8); }
    };
    u32x4 wq, wk, wv, wx[4];
    if ((int)blockIdx.x < MTOK / 8) issue((int)blockIdx.x, wq, wk, wv, wx);
    for (int it = blockIdx.x; it < MTOK / 8; it += gridDim.x) {
        const int row = it * 8 + wid;
        const bool prm = row < MP;
        const int S = prm ? 256 : 2048, tok0 = prm ? 0 : MP;
        const int b = prm ? (row >> 8) : ((row - MP) >> 11), s = prm ? (row & 255) : ((row - MP) & 2047);
        u32x4 nq = wq, nk = wk, nv = wv, nx[4] = {wx[0], wx[1], wx[2], wx[3]};
        if (it + (int)gridDim.x < MTOK / 8) issue(it + (int)gridDim.x, nq, nk, nv, nx);
        float cs[8], sn[8];
        if (!prm) rope_tables(ropeT, s, lane, cs, sn);
        else {
#pragma unroll
            for (int j = 0; j < 8; ++j) { cs[j] = 1.f; sn[j] = 0.f; }
        }
        float v[8];
        unpack8(wq, v); qk_norm_rope(v, gq, !prm, cs, sn, lane);
#pragma unroll
        for (int j = 0; j < 8; ++j) v[j] *= 0.125f * LOG2E;
        *(u32x4*)(Qd + ((size_t)tok0 * 8 + (size_t)(b * 8 + (lane >> 3)) * S + s) * 64 + (lane & 7) * 8) = pack8(v);
        unpack8(wk, v);
        if (prm) { float ss = 0.f;
#pragma unroll
            for (int j = 0; j < 8; ++j) ss += v[j] * v[j];
            ss += __shfl_xor(ss, 1); ss += __shfl_xor(ss, 2); ss += __shfl_xor(ss, 4);
            const float rs = rsqrtf(ss * (1.f / 64.f) + 1e-6f); float o[8];
#pragma unroll
            for (int j = 0; j < 8; ++j) o[j] = v[j] * rs * gk[j];
            st8f(o_dk + (size_t)row * 512 + lane * 8, o);
        }
        qk_norm_rope(v, gk, !prm, cs, sn, lane);
        *(u32x4*)(Kd + ((size_t)tok0 * 8 + (size_t)(b * 8 + (lane >> 3)) * S + s) * 64 + (lane & 7) * 8) = pack8(v);
        {
            const u32x4 w = wv;
            unpack8(w, v);
            if (prm) st8f(o_dv + (size_t)row * 512 + lane * 8, v);
            const bf16_t e[8] = {(bf16_t)(w.x & 0xffff), (bf16_t)(w.x >> 16), (bf16_t)(w.y & 0xffff), (bf16_t)(w.y >> 16), (bf16_t)(w.z & 0xffff), (bf16_t)(w.z >> 16), (bf16_t)(w.w & 0xffff), (bf16_t)(w.w >> 16)};
#pragma unroll
            for (int j = 0; j < 8; ++j) svt[(lane * 8 + j) * 8 + wid] = e[j];
        }
        {
            float a[8];
#pragma unroll
            for (int j = 0; j < 8; ++j) a[j] = cb[j];
#pragma unroll
            for (int t = 0; t < 4; ++t) {
                const int sp = s + t - 2;
                if (sp >= 0 && sp < S) { float x[8]; unpack8(wx[t], x);
#pragma unroll
                    for (int j = 0; j < 8; ++j) a[j] += x[j] * cw[t][j]; }
            }
            *(u32x4*)(xc + (size_t)row * 512 + lane * 8) = pack8(a);
        }
        __syncthreads();
        {
            const int row0 = it * 8, s0 = prm ? (row0 & 255) : ((row0 - MP) & 2047), b0 = prm ? (row0 >> 8) : ((row0 - MP) >> 11);
            const int S0 = prm ? 256 : 2048; const size_t t0 = prm ? 0 : (size_t)MP * 512;
            *(u32x4*)(Vtd + t0 + ((size_t)b0 * 512 + tid) * S0 + s0) = *(const u32x4*)(svt + tid * 8);
        }
        __syncthreads();
        wq = nq; wk = nk; wv = nv; wx[0] = nx[0]; wx[1] = nx[1]; wx[2] = nx[2]; wx[3] = nx[3];
    }
}

DI void phase_post_odd(const Params& p, unsigned char* shm) {
    const int tid = tidx(), lane = tid & 63, wid = tid >> 6;
    unsigned char* ws = p.ws;
    const bf16_t* QKV = (const bf16_t*)(ws + P_QKV);
    bf16_t* Qw = (bf16_t*)(ws + P_ATT); bf16_t* Kw = (bf16_t*)(ws + P_ATT + 48 * MiB); bf16_t* Vtw = (bf16_t*)(ws + P_ATT + 60 * MiB);
    float* o_wk = p.out + (size_t)MTOK * DM + (size_t)2 * MP * 512 + 32768; float* o_wv = o_wk + (size_t)MP * 256;
    bf16_t* svt = (bf16_t*)shm;
    float* ropeT = (float*)(shm + 16384); rope_table_fill(ropeT);
    float gq[8], gk[8];
#pragma unroll
    for (int j = 0; j < 8; ++j) { gq[j] = p.o_q_g[(lane & 7) * 8 + j]; gk[j] = p.o_k_g[(lane & 7) * 8 + j]; }
    u32x4 pw0 = {0u, 0u, 0u, 0u}, pw1 = pw0, pw2 = pw0;
    if ((int)blockIdx.x < MTOK / 8) { const bf16_t* zn = QKV + (size_t)((int)blockIdx.x * 8 + wid) * 1536; pw0 = *(const u32x4*)(zn + lane * 8); pw1 = *(const u32x4*)(zn + 512 + lane * 8); pw2 = *(const u32x4*)(zn + 1024 + lane * 8); }
    for (int it = blockIdx.x; it < MTOK / 8; it += gridDim.x) {
        const int row = it * 8 + wid;
        const bool prm = row < MP;
        const int S = prm ? 256 : 2048, tok0 = prm ? 0 : MP;
        const int b = prm ? (row >> 8) : ((row - MP) >> 11), s = prm ? (row & 255) : ((row - MP) & 2047);
        float cs[8], sn[8];
        if (!prm) rope_tables(ropeT, s, lane, cs, sn);
        else {
#pragma unroll
            for (int j = 0; j < 8; ++j) { cs[j] = 1.f; sn[j] = 0.f; }
        }
        const u32x4 wq2[2] = {pw0, pw1};
        const u32x4 wkv = pw2;
        if (it + (int)gridDim.x < MTOK / 8) { const bf16_t* zn = QKV + (size_t)((it + (int)gridDim.x) * 8 + wid) * 1536; pw0 = *(const u32x4*)(zn + lane * 8); pw1 = *(const u32x4*)(zn + 512 + lane * 8); pw2 = *(const u32x4*)(zn + 1024 + lane * 8); }
        float v[8];
#pragma unroll
        for (int ps = 0; ps < 2; ++ps) {
            unpack8(wq2[ps], v); qk_norm_rope(v, gq, !prm, cs, sn, lane);
#pragma unroll
            for (int j = 0; j < 8; ++j) v[j] *= 0.125f * LOG2E;
            const int head = ps * 8 + (lane >> 3);
            *(u32x4*)(Qw + ((size_t)tok0 * 16 + (size_t)(b * 16 + head) * S + s) * 64 + (lane & 7) * 8) = pack8(v);
        }
        const u32x4 w = wkv;
        unpack8(w, v);
        if (lane >= 32) {
            if (prm) st8f(o_wv + (size_t)row * 256 + (lane - 32) * 8, v);
            const bf16_t e[8] = {(bf16_t)(w.x & 0xffff), (bf16_t)(w.x >> 16), (bf16_t)(w.y & 0xffff), (bf16_t)(w.y >> 16), (bf16_t)(w.z & 0xffff), (bf16_t)(w.z >> 16), (bf16_t)(w.w & 0xffff), (bf16_t)(w.w >> 16)};
#pragma unroll
            for (int j = 0; j < 8; ++j) svt[((lane - 32) * 8 + j) * 8 + wid] = e[j];
        }
        {
            float ss = 0.f;
#pragma unroll
            for (int j = 0; j < 8; ++j) ss += v[j] * v[j];
            ss += __shfl_xor(ss, 1); ss += __shfl_xor(ss, 2); ss += __shfl_xor(ss, 4);
            const float rs = rsqrtf(ss * (1.f / 64.f) + 1e-6f);
            if (prm && lane < 32) { float o[8];
#pragma unroll
                for (int j = 0; j < 8; ++j) o[j] = v[j] * rs * gk[j];
                st8f(o_wk + (size_t)row * 256 + lane * 8, o); }
        }
        qk_norm_rope(v, gk, !prm, cs, sn, lane);
        if (lane < 32) *(u32x4*)(Kw + ((size_t)tok0 * 4 + (size_t)(b * 4 + (lane >> 3)) * S + s) * 64 + (lane & 7) * 8) = pack8(v);
        __syncthreads();
        if (tid < 256) {
            const int row0 = it * 8, s0 = prm ? (row0 & 255) : ((row0 - MP) & 2047), b0 = prm ? (row0 >> 8) : ((row0 - MP) >> 11);
            const int S0 = prm ? 256 : 2048; const size_t t0 = prm ? 0 : (size_t)MP * 256;
            *(u32x4*)(Vtw + t0 + ((size_t)b0 * 256 + tid) * S0 + s0) = *(const u32x4*)(svt + tid * 8);
        }
        __syncthreads();
    }
}

template <int BATCH>
DI void scan_item(const Params& p, unsigned char* shm, bool prm, int b, int cgi) {
    const int tid = tidx(), l16 = tid & 15, chunk = tid >> 4;
    unsigned char* ws = p.ws;
    const int S = prm ? 256 : 2048, tok0 = prm ? b * 256 : MP + b * 2048, Lc = S >> 5;
    const int ch = cgi * 64 + l16 * 4;
    const bf16_t* GT = (const bf16_t*)(ws + P_GT);
    bf16_t* Aout = (bf16_t*)(ws + P_H);
    float* sA = (float*)shm; float* sB = sA + 2048;
    float* o_st = p.out + (size_t)MTOK * DM + (size_t)2 * MP * 512;
#pragma unroll
    for (int dir = 0; dir < 2; ++dir) {
        const _Float16* LA = (const _Float16*)(ws + P_LAU) + (size_t)dir * MTOK * 512;
        const _Float16* UU = (const _Float16*)(ws + P_LAU + 48 * MiB) + (size_t)dir * MTOK * 512;
        float A[4] = {1.f, 1.f, 1.f, 1.f}, B[4] = {0.f, 0.f, 0.f, 0.f};
        for (int i0 = 0; i0 < Lc; i0 += BATCH) {
            h16x4 av[BATCH], uv[BATCH];
#pragma unroll
            for (int q = 0; q < BATCH; ++q) { const int pos = dir == 0 ? chunk * Lc + i0 + q : S - 1 - (chunk * Lc + i0 + q); const size_t idx = (size_t)(tok0 + pos) * 512 + ch; av[q] = *(const h16x4*)(LA + idx); uv[q] = *(const h16x4*)(UU + idx); }
#pragma unroll
            for (int q = 0; q < BATCH; ++q)
#pragma unroll
                for (int j = 0; j < 4; ++j) { const float e = __builtin_amdgcn_exp2f((float)av[q][j] * LOG2E); B[j] = e * B[j] + __builtin_amdgcn_sqrtf(fmaxf(1.f - e * e, 0.f)) * (float)uv[q][j]; A[j] *= e; }
        }
        *(float4*)(sA + chunk * 64 + l16 * 4) = make_float4(A[0], A[1], A[2], A[3]);
        *(float4*)(sB + chunk * 64 + l16 * 4) = make_float4(B[0], B[1], B[2], B[3]);
        __syncthreads();
        float hh[4];
#pragma unroll
        for (int j = 0; j < 4; ++j) hh[j] = prm ? 0.f : p.state_lru[(size_t)(b * 2 + dir) * 512 + ch + j];
        for (int cc = 0; cc < chunk; ++cc) {
            const float4 a4 = *(const float4*)(sA + cc * 64 + l16 * 4), b4 = *(const float4*)(sB + cc * 64 + l16 * 4);
            hh[0] = a4.x * hh[0] + b4.x; hh[1] = a4.y * hh[1] + b4.y; hh[2] = a4.z * hh[2] + b4.z; hh[3] = a4.w * hh[3] + b4.w;
        }
        for (int i0 = 0; i0 < Lc; i0 += BATCH) {
            h16x4 av[BATCH], uv[BATCH]; u32x2 gv[BATCH], hv[BATCH];
#pragma unroll
            for (int q = 0; q < BATCH; ++q) { const int pos = dir == 0 ? chunk * Lc + i0 + q : S - 1 - (chunk * Lc + i0 + q); const size_t t = (size_t)(tok0 + pos); av[q] = *(const h16x4*)(LA + t * 512 + ch); uv[q] = *(const h16x4*)(UU + t * 512 + ch);
                if (dir == 1) { gv[q] = *(const u32x2*)(GT + t * 512 + ch); hv[q] = *(const u32x2*)(Aout + t * 1024 + ch); } }
#pragma unroll
            for (int q = 0; q < BATCH; ++q) {
                const int pos = dir == 0 ? chunk * Lc + i0 + q : S - 1 - (chunk * Lc + i0 + q); const size_t t = (size_t)(tok0 + pos);
                float o[4];
#pragma unroll
                for (int j = 0; j < 4; ++j) { const float e = __builtin_amdgcn_exp2f((float)av[q][j] * LOG2E); hh[j] = e * hh[j] + __builtin_amdgcn_sqrtf(fmaxf(1.f - e * e, 0.f)) * (float)uv[q][j]; o[j] = hh[j]; }
                if (dir == 1) {
                    const float g[4] = {bflo(gv[q].x), bfhi(gv[q].x), bflo(gv[q].y), bfhi(gv[q].y)}, hf[4] = {bflo(hv[q].x), bfhi(hv[q].x), bflo(hv[q].y), bfhi(hv[q].y)};
#pragma unroll
                    for (int j = 0; j < 4; ++j) { const float x = g[j]; const float u2 = 1.5957691216057308f * (x + 0.044715f * x * x * x); o[j] = (hf[j] + hh[j]) * x * fsigmoid(u2); }
                }
                u32x2 w; w.x = pack2(o[0], o[1]); w.y = pack2(o[2], o[3]);
                *(u32x2*)(Aout + t * 1024 + ch) = w;
            }
        }
        if (prm && chunk == 31) {
#pragma unroll
            for (int j = 0; j < 4; ++j) o_st[(size_t)(b * 2 + dir) * 512 + ch + j] = hh[j];
        }
        __syncthreads();
    }
}

struct AttnSeg { const bf16_t* K0; const bf16_t* K1; const bf16_t* Vt; int ldv, kt0, nt; };
#define MFMA32(a, b, c) __builtin_amdgcn_mfma_f32_32x32x16_bf16((a), (b), (c), 0, 0, 0)

template <int NKB, int DV>
DI void attn_load(const AttnSeg& sg, int kt, u32x4 (&kr)[NKB], u32x4 (&vr)[DV / 64]) {
    const int tid = tidx(), key = tid >> 3, part = tid & 7;
    kr[0] = *(const u32x4*)(sg.K0 + (size_t)(kt * 64 + key) * 64 + part * 8);
    if (NKB == 2) kr[NKB - 1] = *(const u32x4*)(sg.K1 + (size_t)(kt * 64 + key) * 64 + part * 8);
#pragma unroll
    for (int i = 0; i < DV / 64; ++i) { const int c = tid + i * 512, e = c >> 3, pt = c & 7; vr[i] = *(const u32x4*)(sg.Vt + (size_t)e * sg.ldv + kt * 64 + pt * 8); }
}
template <int NKB, int DV>
DI void attn_store(unsigned char* buf, const u32x4 (&kr)[NKB], const u32x4 (&vr)[DV / 64]) {
    const int tid = tidx(), key = tid >> 3, part = tid & 7;
#pragma unroll
    for (int nb = 0; nb < NKB; ++nb) *(u32x4*)(buf + nb * (64 * 144) + key * 144 + part * 16) = kr[nb];
#pragma unroll
    for (int i = 0; i < DV / 64; ++i) { const int c = tid + i * 512, e = c >> 3, pt = c & 7; *(u32x4*)(buf + NKB * (64 * 144) + e * 144 + pt * 16) = vr[i]; }
}

template <int NKB, int DV, bool WIN>
DI void attn_run(unsigned char* shm, const AttnSeg& s0, const AttnSeg& s1, const bf16_t* Qmat, int qrow0, int kb, bool mask1, float m_init, float l_init,
                 f32x16 (&O)[DV / 32], float& l_out) {
    constexpr int BUF = (NKB * 64 + DV) * 144;
    const int lane = tidx() & 63, r = lane & 31, h = lane >> 5;
    const int pr = (r & ~12) | ((r & 4) << 1) | ((r & 8) >> 1);
    bf16x8 qf[4];
#pragma unroll
    for (int s = 0; s < 4; ++s) qf[s] = *(const bf16x8*)(Qmat + (size_t)(qrow0 + r) * 64 + 16 * s + 8 * h);
#pragma unroll
    for (int et = 0; et < DV / 32; ++et)
#pragma unroll
        for (int i = 0; i < 16; ++i) O[et][i] = 0.f;
    float m = m_init, l = l_init;
    const int ntot = s0.nt + s1.nt;
    u32x4 krA[NKB], vrA[DV / 64], krB[NKB], vrB[DV / 64];
    auto load_tile = [&](int t, u32x4 (&kr)[NKB], u32x4 (&vr)[DV / 64]) __attribute__((always_inline)) {
        if (t < ntot) { if (t < s0.nt) attn_load<NKB, DV>(s0, s0.kt0 + t, kr, vr); else attn_load<NKB, DV>(s1, s1.kt0 + (t - s0.nt), kr, vr); }
    };
    auto compute_tile = [&](int t, const unsigned char* buf) __attribute__((always_inline)) {
        const bool inseg1 = t >= s0.nt;
        const int kpos0 = inseg1 ? (s1.kt0 + t - s0.nt) * 64 : 0;
        const bool masked = WIN && mask1 && inseg1;
        bool skip = false;
        if (masked) skip = (kpos0 > qrow0 + 31 + 128) || (kpos0 + 63 < qrow0 - 128);
        if (!skip) {
            const unsigned char* kbuf = buf + kb * (64 * 144);
            f32x16 st0, st1;
#pragma unroll
            for (int i = 0; i < 16; ++i) { st0[i] = 0.f; st1[i] = 0.f; }
            const unsigned char* vbuf = buf + NKB * (64 * 144);
            bf16x8 kf[8], vf[2][4];
#pragma unroll
            for (int s = 0; s < 4; ++s) {
                kf[2 * s] = *(const bf16x8*)(kbuf + pr * 144 + (16 * s + 8 * h) * 2);
                kf[2 * s + 1] = *(const bf16x8*)(kbuf + (32 + pr) * 144 + (16 * s + 8 * h) * 2);
            }
            __builtin_amdgcn_sched_barrier(0);
            __builtin_amdgcn_s_setprio(1);
#pragma unroll
            for (int s = 0; s < 4; ++s) { st0 = MFMA32(kf[2 * s], qf[s], st0); st1 = MFMA32(kf[2 * s + 1], qf[s], st1); }
            __builtin_amdgcn_s_setprio(0);
#pragma unroll
            for (int f = 0; f < 4; ++f)
                vf[0][f] = *(const bf16x8*)(vbuf + (32 * (f >> 2) + r) * 144 + (32 * ((f >> 1) & 1) + 16 * (f & 1) + 8 * h) * 2);
            __builtin_amdgcn_sched_barrier(0);
            if (masked) {
                const int qp = qrow0 + r;
#pragma unroll
                for (int i = 0; i < 16; ++i) {
                    const int kp = kpos0 + (i & 7) + 8 * h + 16 * (i >> 3);
                    int d0 = qp - kp; d0 = d0 < 0 ? -d0 : d0; int d1 = qp - (kp + 32); d1 = d1 < 0 ? -d1 : d1;
                    if (d0 > 128) st0[i] = -1e30f;
                    if (d1 > 128) st1[i] = -1e30f;
                }
            }
            float mx = fmaxf(st0[0], st1[0]);
#pragma unroll
            for (int i = 1; i < 16; ++i) mx = fmaxf(mx, fmaxf(st0[i], st1[i]));
            mx = xhalf_max(mx);
            const float mn = fmaxf(m, mx);
            if (__any(mn > m + 8.f)) {
                const float alpha = __builtin_amdgcn_exp2f(m - mn);
                l *= alpha;
#pragma unroll
                for (int et = 0; et < DV / 32; ++et)
#pragma unroll
                    for (int i = 0; i < 16; ++i) O[et][i] *= alpha;
                m = mn;
            }
            float ps = 0.f;
#pragma unroll
            for (int i = 0; i < 16; ++i) { st0[i] = __builtin_amdgcn_exp2f(st0[i] - m); st1[i] = __builtin_amdgcn_exp2f(st1[i] - m); ps += st0[i] + st1[i]; }
            l += ps;
            bf16x8 pf[2][2];
#pragma unroll
            for (int s2 = 0; s2 < 2; ++s2) {
                u32x4 w0, w1;
                w0.x = pack2(st0[8 * s2 + 0], st0[8 * s2 + 1]); w0.y = pack2(st0[8 * s2 + 2], st0[8 * s2 + 3]); w0.z = pack2(st0[8 * s2 + 4], st0[8 * s2 + 5]); w0.w = pack2(st0[8 * s2 + 6], st0[8 * s2 + 7]);
                w1.x = pack2(st1[8 * s2 + 0], st1[8 * s2 + 1]); w1.y = pack2(st1[8 * s2 + 2], st1[8 * s2 + 3]); w1.z = pack2(st1[8 * s2 + 4], st1[8 * s2 + 5]); w1.w = pack2(st1[8 * s2 + 6], st1[8 * s2 + 7]);
                pf[0][s2] = __builtin_bit_cast(bf16x8, w0); pf[1][s2] = __builtin_bit_cast(bf16x8, w1);
            }
#pragma unroll
            for (int b = 0; b < DV / 32; ++b) {
                if (b + 1 < DV / 32) {
#pragma unroll
                    for (int f = 0; f < 4; ++f)
                        vf[(b + 1) & 1][f] = *(const bf16x8*)(vbuf + (32 * (b + 1) + r) * 144 + (32 * ((f >> 1) & 1) + 16 * (f & 1) + 8 * h) * 2);
                }
                __builtin_amdgcn_sched_barrier(0);
                __builtin_amdgcn_s_setprio(1);
#pragma unroll
                for (int f = 0; f < 4; ++f) O[b] = MFMA32(vf[b & 1][f], pf[(f >> 1) & 1][f & 1], O[b]);
                __builtin_amdgcn_s_setprio(0);
                __builtin_amdgcn_sched_barrier(0);
            }
        }
    };
    load_tile(0, krA, vrA); load_tile(1, krB, vrB);
    attn_store<NKB, DV>(shm, krA, vrA);
    __syncthreads();
    load_tile(2, krA, vrA);
    for (int t = 0; t < ntot; t += 2) {
        compute_tile(t, shm);
        attn_store<NKB, DV>(shm + BUF, krB, vrB);
        __syncthreads();
        load_tile(t + 3, krB, vrB);
        compute_tile(t + 1, shm + BUF);
        if (t + 2 < ntot) attn_store<NKB, DV>(shm, krA, vrA);
        __syncthreads();
        load_tile(t + 4, krA, vrA);
    }
    l_out = l + __shfl_xor(l, 32);
}

DI void diff_attn_item(const Params& p, unsigned char* shm, bool prm, int b, int hd, int qblk, float lam) {
    unsigned char* ws = p.ws;
    const int tid = tidx(), lane = tid & 63, wid = tid >> 6, r = lane & 31, h = lane >> 5;
    const int pair = wid >> 1, kb = wid & 1;
    const int S = prm ? 256 : 2048; const size_t tok0 = prm ? 0 : MP;
    const bf16_t* Qd = (const bf16_t*)(ws + P_ATT); const bf16_t* Kd = (const bf16_t*)(ws + P_ATT + 24 * MiB); const bf16_t* Vtd = (const bf16_t*)(ws + P_ATT + 48 * MiB);
    bf16_t* Aout = (bf16_t*)(ws + P_H);
    AttnSeg s0, s1;
    s0.K0 = (const bf16_t*)(ws + OFF_KDC) + (size_t)((b * 4 + hd) * 2) * 512 * 64; s0.K1 = s0.K0 + 512 * 64;
    s0.Vt = (const bf16_t*)(ws + OFF_VDC) + (size_t)(b * 512 + hd * 128) * 512; s0.ldv = 512; s0.kt0 = 0; s0.nt = prm ? 0 : 8;
    s1.K0 = Kd + (tok0 * 8 + (size_t)((b * 4 + hd) * 2) * S) * 64; s1.K1 = s1.K0 + (size_t)S * 64;
    s1.Vt = Vtd + tok0 * 512 + (size_t)(b * 512 + hd * 128) * S; s1.ldv = S; s1.kt0 = 0; s1.nt = S / 64;
    const bf16_t* Qmat = Qd + (tok0 * 8 + (size_t)((b * 4 + hd) * 2 + kb) * S) * 64;
    const int qrow0 = qblk * 128 + pair * 32;
    f32x16 O[4]; float lt;
    attn_run<2, 128, false>(shm, s0, s1, Qmat, qrow0, kb, false, -1e30f, 0.f, O, lt);
    const float inv = 1.f / lt;
    float* X = (float*)shm + pair * 4096;
    if (kb == 1) {
#pragma unroll
        for (int et = 0; et < 4; ++et)
#pragma unroll
            for (int i = 0; i < 16; ++i) X[(et * 16 + i) * 64 + lane] = O[et][i] * inv;
    }
    __syncthreads();
    if (kb == 0) {
        float ss = 0.f;
#pragma unroll
        for (int et = 0; et < 4; ++et)
#pragma unroll
            for (int i = 0; i < 16; ++i) { const float o = O[et][i] * inv - lam * X[(et * 16 + i) * 64 + lane]; O[et][i] = o; ss += o * o; }
        ss += __shfl_xor(ss, 32);
        const float rs = rsqrtf(ss * (1.f / 128.f) + 1e-6f) * 0.8f;
        const size_t row = (size_t)(prm ? b * 256 : MP + b * 2048) + qrow0 + r;
        bf16_t* op = Aout + row * 1024 + 512 + hd * 128;
#pragma unroll
        for (int et = 0; et < 4; ++et)
#pragma unroll
            for (int g = 0; g < 4; ++g) {
                const int e = 32 * et + 8 * g + 4 * h;
                const float4 sg = *(const float4*)(p.e_subln_g + e);
                u32x2 w; w.x = pack2(O[et][4 * g + 0] * rs * sg.x, O[et][4 * g + 1] * rs * sg.y); w.y = pack2(O[et][4 * g + 2] * rs * sg.z, O[et][4 * g + 3] * rs * sg.w);
                *(u32x2*)(op + e) = w;
            }
    }
    __syncthreads();
}

DI void win_attn_item(const Params& p, unsigned char* shm, bool prm, int b, int head, int qblk) {
    unsigned char* ws = p.ws;
    const int tid = tidx(), lane = tid & 63, wid = tid >> 6, r = lane & 31, h = lane >> 5;
    const int S = prm ? 256 : 2048; const size_t tok0 = prm ? 0 : MP; const int kv = head >> 2;
    const bf16_t* Qw = (const bf16_t*)(ws + P_ATT); const bf16_t* Kw = (const bf16_t*)(ws + P_ATT + 48 * MiB); const bf16_t* Vtw = (const bf16_t*)(ws + P_ATT + 60 * MiB);
    bf16_t* Aout = (bf16_t*)(ws + P_H);
    const int q0 = qblk * 256;
    AttnSeg s0, s1;
    s0.K0 = (const bf16_t*)(ws + OFF_KWC) + (size_t)(b * 4 + kv) * 512 * 64; s0.K1 = s0.K0;
    s0.Vt = (const bf16_t*)(ws + OFF_VWC) + (size_t)(b * 256 + kv * 64) * 512; s0.ldv = 512; s0.kt0 = 0; s0.nt = prm ? 0 : 8;
    s1.K0 = Kw + (tok0 * 4 + (size_t)(b * 4 + kv) * S) * 64; s1.K1 = s1.K0;
    s1.Vt = Vtw + tok0 * 256 + (size_t)(b * 256 + kv * 64) * S; s1.ldv = S;
    if (prm) { s1.kt0 = 0; s1.nt = 4; }
    else { const int lo = (q0 - 128 < 0 ? 0 : q0 - 128) >> 6, hi = (q0 + 384 > S ? S : q0 + 384) >> 6; s1.kt0 = lo; s1.nt = hi - lo; }
    const bf16_t* Qmat = Qw + (tok0 * 16 + (size_t)(b * 16 + head) * S) * 64;
    const int qrow0 = q0 + wid * 32;
    f32x16 O[2]; float lt;
    attn_run<1, 64, true>(shm, s0, s1, Qmat, qrow0, 0, !prm, p.o_sink[head] * LOG2E, h == 0 ? 1.f : 0.f, O, lt);
    const float inv = 1.f / lt;
    const size_t row = (size_t)(prm ? b * 256 : MP + b * 2048) + qrow0 + r;
    bf16_t* op = Aout + row * 1024 + head * 64;
#pragma unroll
    for (int et = 0; et < 2; ++et)
#pragma unroll
        for (int g = 0; g < 4; ++g) {
            const int e = 32 * et + 8 * g + 4 * h;
            u32x2 w; w.x = pack2(O[et][4 * g + 0] * inv, O[et][4 * g + 1] * inv); w.y = pack2(O[et][4 * g + 2] * inv, O[et][4 * g + 3] * inv);
            *(u32x2*)(op + e) = w;
        }
}

DI int pop_item(unsigned char* shm, unsigned* counter) {
    int* slot = (int*)(shm + LDS_BYTES + 16);
    if (tidx() == 0) *slot = (int)atomicAdd(counter, 1u);
    __syncthreads();
    const int it = *slot;
    __syncthreads();
    return it;
}
DI unsigned queues_left(unsigned char* shm, unsigned* counters, unsigned limit) {
    int* fl = (int*)(shm + LDS_BYTES + 32);
    const int tid = tidx();
    if (tid < 8) fl[tid] = __hip_atomic_load(counters + tid * 64, __ATOMIC_RELAXED, __HIP_MEMORY_SCOPE_AGENT) < limit ? 1 : 0;
    __syncthreads();
    unsigned m = 0;
#pragma unroll
    for (int q = 0; q < 8; ++q) m |= fl[q] ? (1u << q) : 0u;
    __syncthreads();
    return m;
}
DI unsigned my_xcc() { return ((unsigned)__builtin_amdgcn_s_getreg((3 << 11) | 20) & 0xFu) & 7u; }

DI void phase_mix_even(const Params& p, unsigned char* shm, int cslot) {
    float lam;
    {
        const int lane = tidx() & 63;
        float a = p.e_lam[lane] * p.e_lam[64 + lane], b = p.e_lam[128 + lane] * p.e_lam[192 + lane];
#pragma unroll
        for (int o = 32; o >= 1; o >>= 1) { a += __shfl_xor(a, o); b += __shfl_xor(b, o); }
        lam = __expf(a) - __expf(b) + 0.2f;
    }
    unsigned* counters = (unsigned*)(p.ws + OFF_CNT) + cslot * 512;
    const unsigned x0 = my_xcc();
    unsigned left = 0xffu;
    for (unsigned k = 0; k < 8; ++k) {
        const int x = (int)((x0 + k) & 7u);
        if (k == 1) left = queues_left(shm, counters, 136u);
        if (!((left >> x) & 1u)) continue;
        for (;;) {
            const int it = pop_item(shm, counters + x * 64);
            if (it >= 136) break;
            if (it < 8) scan_item<16>(p, shm, false, x, it);
            else if (it < 72) { const int j = it - 8; diff_attn_item(p, shm, false, x, j >> 4, j & 15, lam); }
            else if (it < 104) { const int j = it - 72; scan_item<8>(p, shm, true, x * 4 + (j >> 3), j & 7); }
            else { const int j = it - 104; diff_attn_item(p, shm, true, x * 4 + (j >> 3), (j >> 1) & 3, j & 1, lam); }
        }
    }
}
DI void phase_mix_odd(const Params& p, unsigned char* shm, int cslot) {
    unsigned* counters = (unsigned*)(p.ws + OFF_CNT) + 1024 + cslot * 512;
    const unsigned x0 = my_xcc();
    unsigned left = 0xffu;
    for (unsigned k = 0; k < 8; ++k) {
        const int x = (int)((x0 + k) & 7u);
        if (k == 1) left = queues_left(shm, counters, 192u);
        if (!((left >> x) & 1u)) continue;
        for (;;) {
            const int it = pop_item(shm, counters + x * 64);
            if (it >= 192) break;
            if (it < 128) win_attn_item(p, shm, false, x, it >> 3, it & 7);
            else { const int j = it - 128; win_attn_item(p, shm, true, x * 4 + (j >> 4), j & 15, 0); }
        }
    }
}

#define XB_TMO      128
#define XB_XCNT(j)  (256  + 64 * (j))
#define XB_XSUB(j)  (1280 + 64 * (j))
#define XB_XGEN(j)  (2304 + 64 * (j))
#define XB_TOP      3328
#define XB_TOPGEN   3392
#define XCD_BAR_WORDS 3456
#define XB_SPIN_CAP (1u << 18)
#define LAS __attribute__((address_space(3)))
DI unsigned xb_ld(unsigned* p)              { return __hip_atomic_load(p, __ATOMIC_RELAXED, __HIP_MEMORY_SCOPE_AGENT); }
DI unsigned xb_add(unsigned* p, unsigned v) { return __hip_atomic_fetch_add(p, v, __ATOMIC_RELAXED, __HIP_MEMORY_SCOPE_AGENT); }
DI unsigned xb_xcc_id() { return (unsigned)__builtin_amdgcn_s_getreg((3 << 11) | 20) & 0xFu; }
#define XB_SPIN(cond, bar) do { unsigned _sp = 0; while (cond) { __builtin_amdgcn_s_sleep(1); \
    if ((++_sp & 255u) == 0u) { if (xb_ld(&(bar)[XB_TMO])) break; if (_sp > XB_SPIN_CAP) { atomicAdd(&(bar)[XB_TMO], 1u); break; } } } } while (0)
struct XcdBarrier { unsigned* bar; unsigned x; volatile LAS unsigned* st; };
DI XcdBarrier xcd_barrier_post(unsigned* bar, volatile LAS unsigned* st) {
    XcdBarrier b; b.bar = bar; b.x = xb_xcc_id(); b.st = st;
    if (threadIdx.x == 0) (void)xb_add(&bar[XB_XCNT(b.x)], 1u);
    return b;
}
DI void xcd_barrier_complete(unsigned* bar, unsigned x, unsigned& nloc, unsigned& nx) {
    const unsigned G = gridDim.x * gridDim.y * gridDim.z;
    unsigned sum, cnt, mine, sp = 0u;
    for (;;) {
        sum = 0u; cnt = 0u; mine = 0u;
#pragma unroll
        for (unsigned j = 0; j < 16; ++j) { const unsigned c = xb_ld(&bar[XB_XCNT(j)]); sum += c; cnt += (c > 0u) ? 1u : 0u; mine = (j == x) ? c : mine; }
        if (sum == G) break;
        __builtin_amdgcn_s_sleep(1);
        if ((++sp & 255u) == 0u) { if (xb_ld(&bar[XB_TMO])) break; if (sp > XB_SPIN_CAP) { atomicAdd(&bar[XB_TMO], 1u); break; } }
    }
    nloc = mine > 0u ? mine : 1u; nx = cnt > 0u ? cnt : 1u;
}
DI void xcd_barrier(const XcdBarrier& b) {
    asm volatile("s_waitcnt vmcnt(0)" ::: "memory");
    __syncthreads();
    if (threadIdx.x == 0) {
        unsigned* bar = b.bar;
        __builtin_amdgcn_s_waitcnt(0);
        unsigned nloc = b.st[0], nx = b.st[1];
        if (nloc == 0u) { xcd_barrier_complete(bar, b.x, nloc, nx); b.st[0] = nloc; b.st[1] = nx; }
        const unsigned old = xb_add(&bar[XB_XSUB(b.x)], 1u);
        const unsigned gen = old / nloc;
        if (old + 1u == (gen + 1u) * nloc) {
            __builtin_amdgcn_fence(__ATOMIC_RELEASE, "agent");
            asm volatile("s_waitcnt vmcnt(0)" ::: "memory");
            const unsigned og = xb_add(&bar[XB_TOP], 1u);
            const unsigned tg = og / nx;
            if (og + 1u == (tg + 1u) * nx) xb_add(&bar[XB_TOPGEN], 1u);
            else XB_SPIN(xb_ld(&bar[XB_TOPGEN]) == tg, bar);
            __builtin_amdgcn_fence(__ATOMIC_ACQUIRE, "agent");
            xb_add(&bar[XB_XGEN(b.x)], 1u);
            asm volatile("s_waitcnt vmcnt(0)" ::: "memory");
        } else {
            XB_SPIN(xb_ld(&bar[XB_XGEN(b.x)]) == gen, bar);
            __builtin_amdgcn_fence(__ATOMIC_ACQUIRE, "agent");
            asm volatile("s_waitcnt vmcnt(0)" ::: "memory");
        }
    }
    __syncthreads();
}

DI void run_phase(const Params& p, unsigned char* shm, int ph, int cslot) {
    unsigned char* ws = p.ws;
    const float* modbuf = (const float*)(ws + OFF_MOD);
    bf16_t* H = (bf16_t*)(ws + P_H);
#ifndef TESTQ
    if (ph == 0) { phase_prep(p, shm); return; }
#endif
    const int l = (ph - 1) < 12 ? 0 : 1;
    int q = ph - 1 - l * 12;
    if (l == 1 && q >= 6) q += 1;
#ifdef TESTQ
    if (q != TESTQ || l != TESTL) return;
#endif
    switch (q) {
        case 0: phase_norm(p, l, 0, l == 0); break;
        case 1: { EpiSwiglu E{(bf16_t*)(ws + P_U)}; run_gemm(shm, H, (const bf16_t*)(ws + OFF_W13 + (size_t)(l * 2 + 0) * SZ_W13), 5632, 1024, E); } break;
        case 2: { EpiResid3 E{l == 0 ? p.x_prompt : p.out, l == 0 ? p.x_sample : p.out + (size_t)MP * DM, p.out, modbuf + (size_t)l * 9 * 9216 + 2 * 1024, 0.5f, 0};
                  run_gemm_resid192(shm, (const bf16_t*)(ws + P_U), (const bf16_t*)(ws + OFF_W2 + (size_t)(l * 2 + 0) * SZ_W2), DFF, E); } break;
        case 3: phase_norm(p, l, 1, false); break;
        case 4: if (l == 0) { EpiSplit E{(bf16_t*)(ws + P_XR), (bf16_t*)(ws + P_GT), (bf16_t*)(ws + P_QKV), 512, 512, 1536, 2, 2}; run_gemm(shm, H, (const bf16_t*)(ws + OFF_EWIN), 2560, 1024, E); }
                else { EpiSplit E{(bf16_t*)(ws + P_QKV), (bf16_t*)(ws + P_QKV), (bf16_t*)(ws + P_QKV), 1536, 1536, 1536, 0, 0}; run_gemm(shm, H, (const bf16_t*)(ws + OFF_OWIN), 1536, 1024, E); } break;
        case 5: if (l == 0) phase_post_even(p, shm); else phase_post_odd(p, shm); break;
        case 6: { EpiGates E{(const bf16_t*)(ws + P_H), (_Float16*)(ws + P_LAU), (_Float16*)(ws + P_LAU + 48 * MiB), p.e_lru_ba, p.e_lru_bi, p.e_lru_lam};
                  pg8::StaticOrder S; S.init(MTOK, 2048, (int)gridDim.x, (int)blockIdx.x);
                  pg8::gemm_phase<EpiGates, pg8::StaticOrder>((PG8_LAS unsigned char*)shm, pg8::Gemm{(const bf16_t*)(ws + P_H), (const bf16_t*)(ws + OFF_WG), MTOK, 2048, 512, 2, 128}, S, E); } break;
        case 7: if (l == 0) phase_mix_even(p, shm, cslot); else phase_mix_odd(p, shm, cslot); break;
        case 8: { EpiResid3 E{p.out, p.out + (size_t)MP * DM, p.out, modbuf + (size_t)l * 9 * 9216 + 5 * 1024, 1.0f, 0};
                  run_gemm_resid192(shm, H, (const bf16_t*)(ws + (l == 0 ? OFF_EWOUT : OFF_OWOUT)), 1024, E); } break;
        case 9: phase_norm(p, l, 2, false); break;
        case 10: { EpiSwiglu E{(bf16_t*)(ws + P_U)}; run_gemm(shm, H, (const bf16_t*)(ws + OFF_W13 + (size_t)(l * 2 + 1) * SZ_W13), 5632, 1024, E); } break;
        case 11: { EpiResid3 E{p.out, p.out + (size_t)MP * DM, p.out, modbuf + (size_t)l * 9 * 9216 + 8 * 1024, 0.5f, 0};
                   run_gemm_resid192(shm, (const bf16_t*)(ws + P_U), (const bf16_t*)(ws + OFF_W2 + (size_t)(l * 2 + 1) * SZ_W2), DFF, E); } break;
        default: break;
    }
}

__global__ void __launch_bounds__(512) trunk_megakernel(Params p) {
    extern __shared__ __attribute__((aligned(16))) unsigned char shm[];
    cg::grid_group grid = cg::this_grid();
    volatile LAS unsigned* st = (volatile LAS unsigned*)(shm + LDS_BYTES);
    if (threadIdx.x == 0) { st[0] = 0u; st[1] = 0u; }
    __syncthreads();
    XcdBarrier xb = xcd_barrier_post((unsigned*)(p.ws + OFF_BAR), st);
    for (int ph = p.p0; ph < p.p1; ++ph) {
        run_phase(p, shm, ph, 0);
        if (PROBE_PH >= 0 && ph == PROBE_PH) { xcd_barrier(xb); run_phase(p, shm, ph, 1); }
        if (ph + 1 < p.p1) { if (ph == p.p0) grid.sync(); else xcd_barrier(xb); }
    }
}

extern "C" void kernel_launch(void* const* d_in, const int* in_sizes, int n_in, void* d_out, int out_size, void* d_ws, size_t ws_size, hipStream_t stream) {
    static int grid_blocks = 0;
    if (!grid_blocks) {
        int dev = 0, cus = 0, per_cu = 0;
        hipGetDevice(&dev);
        hipDeviceGetAttribute(&cus, hipDeviceAttributeMultiprocessorCount, dev);
        hipFuncSetAttribute((const void*)trunk_megakernel, hipFuncAttributeMaxDynamicSharedMemorySize, LDS_TOTAL);
        hipOccupancyMaxActiveBlocksPerMultiprocessor(&per_cu, trunk_megakernel, 512, LDS_TOTAL);
        if (per_cu < 1) per_cu = 1;
        grid_blocks = cus * per_cu;
    }
    if (ws_size < WS_NEED + MiB) {
 fprintf(stderr, "workspace too small: %zu < %zu\n", ws_size, (size_t)WS_NEED); return; }
    Params p{};
    const float** pp = (const float**)&p;
    for (int i = 0; i < 33; ++i) pp[i] = (const float*)d_in[i];
    p.out = (float*)d_out; p.ws = (unsigned char*)d_ws;
#if MULTI_LAUNCH
    for (int ph = 0; ph < NPHASE; ++ph) {
        p.p0 = ph; p.p1 = ph + 1;
        hipLaunchKernelGGL(trunk_megakernel, dim3(grid_blocks), dim3(512), LDS_TOTAL, stream, p);
    }
#else
    p.p0 = 0; p.p1 = NPHASE;
    hipMemsetAsync((unsigned char*)d_ws + OFF_CNT, 0, CNT_BYTES + XCD_BAR_WORDS * 4, stream);
    void* args[] = {&p};
    hipError_t e = hipLaunchCooperativeKernel((void*)trunk_megakernel, dim3(grid_blocks), dim3(512), args, LDS_TOTAL, stream);
    if (e != hipSuccess) fprintf(stderr, "cooperative launch failed: %s (grid %d)\n", hipGetErrorString(e), grid_blocks);
#endif
}
```
